# Optimizing an MI355X kernel written in HIP

```python
import math
import jax, jax.numpy as jnp
from jax import lax
import numpy as np

D_MODEL = 1024
BATCH = 8
SEQ = 2048
DEPTH = 2

GRID_W = 64
CTX_LEN = 256
MLP_HIDDEN = 4 * D_MODEL
ADA_CHUNKS = 6
SHORT_CONV = 3
EPS = 1e-6

RW_WIDTH = D_MODEL // 2
RW_HEAD_DIM = 64
RW_HEADS = RW_WIDTH // RW_HEAD_DIM
RW_DECAY_RANK = 64
RW_AAA_RANK = 64
RW_GATE_RANK = 128
RW_COLS = 3 * RW_WIDTH + RW_DECAY_RANK + RW_AAA_RANK + RW_GATE_RANK
RW_SPLITS = (RW_WIDTH, 2 * RW_WIDTH, 3 * RW_WIDTH, 3 * RW_WIDTH + RW_DECAY_RANK,
             3 * RW_WIDTH + RW_DECAY_RANK + RW_AAA_RANK)
RW_GN_EPS = 64e-5
HY_WIDTH = D_MODEL - RW_WIDTH
HY_COLS = 3 * HY_WIDTH
HY_BANDS = 16
HY_EMB = 1 + 2 * HY_BANDS
HY_ORDER = 64
HY_FAST_DECAY = 0.3
HY_SLOW_DECAY = 1.5
HY_TARGET = 1e-2
AB_COLS = RW_COLS + HY_COLS
DN_HEADS = 8
DN_HEAD_DIM = D_MODEL // DN_HEADS
DN_DIM = DN_HEADS * DN_HEAD_DIM
DN_CHUNK = 64
DN_COLS = 4 * DN_DIM + 4 * DN_HEADS

kernel_name = 'hybrid_rwkv7_hyena_gdn_diffusion_trunk'


def rmsnorm(x, w):
    xf = x.astype(jnp.float32)
    y = xf * lax.rsqrt(jnp.mean(xf * xf, axis=-1, keepdims=True) + EPS)
    return y.astype(x.dtype) * w


def modulate(h, shift, scale):
    return h * (1 + scale) + shift


def l2norm(t):
    tf = t.astype(jnp.float32)
    return tf * lax.rsqrt(jnp.sum(tf * tf, axis=-1, keepdims=True) + EPS)


def short_conv(u, w):
    pad = SHORT_CONV // 2
    return lax.conv_general_dilated(u, w[:, None, :], window_strides=(1,), padding=((pad, pad),),
                                    dimension_numbers=('NWC', 'WIO', 'NWC'),
                                    feature_group_count=u.shape[-1])


def token_shift_mix(p, mu):
    prev = jnp.pad(p, ((0, 0), (1, 0), (0, 0)))[:, :-1]
    nxt = jnp.pad(p, ((0, 0), (0, 1), (0, 0)))[:, 1:]
    return p + mu * (0.5 * (prev + nxt) - p)


def rwkv_prep(p, mu, w0, w_up, a0, a_up, g_up, k_k, k_a):
    B, L, _ = p.shape
    p = token_shift_mix(p, mu).astype(jnp.float32)
    r, k, v, wl, al, gl = jnp.split(p, RW_SPLITS, axis=-1)
    heads = lambda t: t.reshape(B, L, RW_HEADS, RW_HEAD_DIM)
    kk = l2norm(heads(k * k_k))
    wl = jnp.tanh(wl)
    dirs = []
    for d in range(2):
        w_log = -jax.nn.softplus(-(w0[d] + wl @ w_up[d])) - 0.5
        a = jax.nn.sigmoid(a0[d] + al @ a_up[d])
        k_d = k * (1 + (a - 1) * k_a)
        dirs.append((heads(jnp.exp(-jnp.exp(w_log))), heads(k_d), heads(a) * kk))
    g = jax.nn.sigmoid(gl) @ g_up
    return heads(r), heads(v), kk, g, dirs


def rwkv_scan(S0, r, v, kk, decay, k, b, reverse):
    xs = tuple(jnp.moveaxis(t, 1, 0) for t in (r, v, kk, decay, k, b))

    def step(S, inp):
        r_t, v_t, kk_t, w_t, k_t, b_t = inp
        sa = -jnp.einsum('bhvk,bhk->bhv', S, kk_t)
        S = S * w_t[:, :, None, :] + sa[..., None] * b_t[:, :, None, :] + v_t[..., None] * k_t[:, :, None, :]
        return S, jnp.einsum('bhvk,bhk->bhv', S, r_t)

    S, ys = lax.scan(step, S0, xs, reverse=reverse)
    return jnp.moveaxis(ys, 0, 1), S


def rwkv_output(y, prep, r_k, ln_w, ln_b):
    r, v, _, g, dirs = prep
    B, L = y.shape[:2]
    mean = jnp.mean(y, axis=-1, keepdims=True)
    var = jnp.mean(jnp.square(y - mean), axis=-1, keepdims=True)
    yn = (y - mean) * lax.rsqrt(var + RW_GN_EPS)
    bonus = sum(jnp.sum(r * k_d * r_k, axis=-1, keepdims=True) for _, k_d, _ in dirs) * v
    return (yn.reshape(B, L, RW_WIDTH) * ln_w + ln_b + bonus.reshape(B, L, RW_WIDTH)) * g


def hyena_filter(L, f_w1, f_b1, f_w2, f_b2, f_w3, f_b3, f_w4, freq):
    t = jnp.linspace(0.0, 1.0, L, dtype=jnp.float32)[:, None]
    w = 2 * math.pi * jnp.arange(L, dtype=jnp.float32)[:, None] / L
    f = jnp.linspace(1e-4, HY_BANDS - 1, HY_BANDS, dtype=jnp.float32)[None, :]
    z = jnp.concatenate([t, jnp.cos(f * w), -jnp.sin(f * w)], axis=-1)
    h = jnp.sin(freq * (z @ f_w1 + f_b1))
    h = jnp.sin(freq * (h @ f_w2 + f_b2))
    h = jnp.sin(freq * (h @ f_w3 + f_b3))
    h = h @ f_w4
    deltas = jnp.abs(jnp.linspace(math.log(HY_TARGET) / HY_SLOW_DECAY, math.log(HY_TARGET) / HY_FAST_DECAY,
                                  HY_WIDTH, dtype=jnp.float32))
    h = h * jnp.exp(-t * jnp.tile(deltas, 2))
    h_f, h_b = jnp.split(h, 2, axis=-1)
    kern = jnp.concatenate([h_f, jnp.zeros((1, HY_WIDTH), h.dtype), h_b[:0:-1]], axis=0)
    return kern / jnp.sum(jnp.abs(kern), axis=0, keepdims=True)


def hyena_seq(u, conv_w, conv_b, skip, filt):
    L = u.shape[1]
    u = short_conv(u, conv_w) + conv_b
    x0, x1, v = jnp.split(u, 3, axis=-1)
    s = (x1 * v).astype(jnp.float32)
    kern = hyena_filter(L, *filt)
    y = jnp.fft.irfft(jnp.fft.rfft(s, n=2 * L, axis=1) * jnp.fft.rfft(kern, axis=0)[None], n=2 * L, axis=1)[:, :L]
    return x0 * (y + s * skip)


def rwkv_hyena_mixer(h_ctx, h_lat, w_in, w_out, rw_in, rw_out, hy_conv, hy_filt, with_ctx_out):
    p_ctx, p_lat = h_ctx @ w_in, h_lat @ w_in
    prep_c = rwkv_prep(p_ctx[..., :RW_COLS], *rw_in)
    prep_l = rwkv_prep(p_lat[..., :RW_COLS], *rw_in)
    S0 = jnp.zeros((h_lat.shape[0], RW_HEADS, RW_HEAD_DIM, RW_HEAD_DIM), jnp.float32)
    y_c, y_l = 0.0, 0.0
    for d, rev in enumerate((False, True)):
        yc_d, S_c = rwkv_scan(S0, prep_c[0], prep_c[1], prep_c[2], *prep_c[4][d], reverse=rev)
        yl_d, _ = rwkv_scan(S_c, prep_l[0], prep_l[1], prep_l[2], *prep_l[4][d], reverse=rev)
        y_c, y_l = y_c + yc_d, y_l + yl_d
    a_lat = rwkv_output(y_l, prep_l, *rw_out)
    b_lat = hyena_seq(p_lat[..., RW_COLS:], *hy_conv, hy_filt)
    y_lat = jnp.concatenate([a_lat, b_lat], axis=-1).astype(h_lat.dtype) @ w_out
    y_ctx = None
    if with_ctx_out:
        a_ctx = rwkv_output(y_c, prep_c, *rw_out)
        b_ctx = hyena_seq(p_ctx[..., RW_COLS:], *hy_conv, hy_filt)
        y_ctx = jnp.concatenate([a_ctx, b_ctx], axis=-1).astype(h_ctx.dtype) @ w_out
    return y_ctx, y_lat


def to_chunks(t):
    B, L, H = t.shape[:3]
    t = t.reshape((B, L // DN_CHUNK, DN_CHUNK, H) + t.shape[3:])
    return jnp.moveaxis(t, 3, 2).swapaxes(0, 1)


def from_chunks(t):
    t = jnp.moveaxis(t.swapaxes(0, 1), 2, 3)
    return t.reshape((t.shape[0], -1) + t.shape[3:])


def gdn_chunked(q, k, v, g, beta, S0):
    K = q.shape[-1]
    q = to_chunks(q.astype(jnp.float32) * K ** -0.5)
    k = to_chunks(k.astype(jnp.float32))
    v = to_chunks(v.astype(jnp.float32))
    g = jnp.cumsum(to_chunks(g.astype(jnp.float32)), axis=-1)
    beta = to_chunks(beta.astype(jnp.float32))
    idx = jnp.arange(DN_CHUNK)
    incl = idx[:, None] >= idx[None, :]
    strict = idx[:, None] > idx[None, :]
    diff = g[..., :, None] - g[..., None, :]
    decay = jnp.where(incl, jnp.exp(jnp.where(incl, diff, 0.0)), 0.0)
    kb = k * beta[..., None]
    lower = jnp.where(strict, jnp.einsum('nbhck,nbhsk->nbhcs', kb, k) * decay, 0.0)
    A = lower + jnp.eye(DN_CHUNK, dtype=jnp.float32)
    solve = lambda rhs: lax.linalg.triangular_solve(A, rhs, left_side=True, lower=True)
    u = solve(v * beta[..., None])
    w = solve(kb * jnp.exp(g)[..., None])
    qk = jnp.einsum('nbhck,nbhsk->nbhcs', q, k) * decay

    def step(S, inp):
        q_c, k_c, u_c, w_c, g_c, qk_c = inp
        v_new = u_c - jnp.einsum('bhck,bhkv->bhcv', w_c, S)
        o = (jnp.einsum('bhck,bhkv->bhcv', q_c * jnp.exp(g_c)[..., None], S)
             + jnp.einsum('bhcs,bhsv->bhcv', qk_c, v_new))
        g_last = g_c[..., -1:]
        S = S * jnp.exp(g_last)[..., None] + jnp.einsum(
            'bhck,bhcv->bhkv', k_c * jnp.exp(g_last - g_c)[..., None], v_new)
        return S, o

    S, o = lax.scan(step, S0, (q, k, u, w, g, qk))
    return from_chunks(o), S


def gdn_prep(p, conv_w, A_log, dt_bias):
    B, L, _ = p.shape
    qkv, z, a, b = jnp.split(p, (3 * DN_DIM, 4 * DN_DIM, 4 * DN_DIM + 2 * DN_HEADS), axis=-1)
    qkv = jax.nn.silu(short_conv(qkv, conv_w))
    q, k, v = [t.reshape(B, L, DN_HEADS, DN_HEAD_DIM) for t in jnp.split(qkv, 3, axis=-1)]
    a = a.reshape(B, L, 2, DN_HEADS).astype(jnp.float32)
    b = b.reshape(B, L, 2, DN_HEADS).astype(jnp.float32)
    g = -jnp.exp(A_log) * jax.nn.softplus(a + dt_bias)
    beta = jax.nn.sigmoid(b)
    return l2norm(q), l2norm(k), v, z, g, beta


def gated_rmsnorm(o, z, w):
    B, L = o.shape[:2]
    on = o * lax.rsqrt(jnp.mean(o * o, axis=-1, keepdims=True) + EPS) * w
    return (on.reshape(B, L, DN_DIM) * jax.nn.silu(z.astype(jnp.float32))).astype(z.dtype)


def deltanet_mixer(h_ctx, h_lat, w_in, conv_w, A_log, dt_bias, norm_w, w_out, with_ctx_out):
    q_c, k_c, v_c, z_c, g_c, b_c = gdn_prep(h_ctx @ w_in, conv_w, A_log, dt_bias)
    q_l, k_l, v_l, z_l, g_l, b_l = gdn_prep(h_lat @ w_in, conv_w, A_log, dt_bias)
    S0 = jnp.zeros((h_lat.shape[0], DN_HEADS, DN_HEAD_DIM, DN_HEAD_DIM), jnp.float32)
    o_c, o_l = 0.0, 0.0
    for d in range(2):
        fl = (lambda t: jnp.flip(t, axis=1)) if d == 1 else (lambda t: t)
        oc_d, S_c = gdn_chunked(fl(q_c), fl(k_c), fl(v_c), fl(g_c[:, :, d]), fl(b_c[:, :, d]), S0)
        ol_d, _ = gdn_chunked(fl(q_l), fl(k_l), fl(v_l), fl(g_l[:, :, d]), fl(b_l[:, :, d]), S_c)
        o_c, o_l = o_c + fl(oc_d), o_l + fl(ol_d)
    y_lat = gated_rmsnorm(o_l, z_l, norm_w) @ w_out
    y_ctx = gated_rmsnorm(o_c, z_c, norm_w) @ w_out if with_ctx_out else None
    return y_ctx, y_lat


def sq_relu_mlp(h, w1, w2):
    return jnp.square(jax.nn.relu(h @ w1)) @ w2


def setup_inputs(seed: int = 0) -> dict:
    key = jax.random.key(seed)
    keys = iter(jax.random.split(key, 48))
    f32 = jnp.float32
    nrm = lambda shape, scale=1.0: jax.random.normal(next(keys), shape, f32) * scale
    uni = lambda shape, lo, hi: jax.random.uniform(next(keys), shape, f32, lo, hi)
    D = D_MODEL
    NE = (DEPTH + 1) // 2
    NO = DEPTH // 2
    dt = jnp.exp(uni((NO, 2, DN_HEADS), math.log(1e-3), math.log(1e-1)))
    return {
        'x': nrm((BATCH, SEQ, D)),
        'c': nrm((BATCH, D)),
        'ctx': nrm((BATCH, CTX_LEN, D)),
        'c_ctx': nrm((D,)),
        'ada_w': nrm((DEPTH, D, ADA_CHUNKS * D), 0.5 * D ** -0.5),
        'ada_b': nrm((DEPTH, ADA_CHUNKS * D), 0.02),
        'norm_mix': 1.0 + nrm((DEPTH, D), 0.02),
        'norm_mlp': 1.0 + nrm((DEPTH, D), 0.02),
        'mlp_w1': nrm((DEPTH, D, MLP_HIDDEN), D ** -0.5),
        'mlp_w2': nrm((DEPTH, MLP_HIDDEN, D), MLP_HIDDEN ** -0.5),
        'final_norm': 1.0 + nrm((D,), 0.02),
        'ab_w_in': nrm((NE, D, AB_COLS), D ** -0.5),
        'ab_w_out': nrm((NE, D, D), D ** -0.5),
        'rw_mu': uni((NE, RW_COLS), 0.0, 1.0),
        'rw_w0': uni((NE, 2, RW_WIDTH), -6.0, -1.0),
        'rw_w_up': nrm((NE, 2, RW_DECAY_RANK, RW_WIDTH), 0.1),
        'rw_a0': nrm((NE, 2, RW_WIDTH), 0.5),
        'rw_a_up': nrm((NE, 2, RW_AAA_RANK, RW_WIDTH), RW_AAA_RANK ** -0.5),
        'rw_g_up': nrm((NE, RW_GATE_RANK, RW_WIDTH), RW_GATE_RANK ** -0.5),
        'rw_k_k': 0.85 + nrm((NE, RW_WIDTH), 0.02),
        'rw_k_a': 1.0 + nrm((NE, RW_WIDTH), 0.02),
        'rw_r_k': nrm((NE, RW_HEADS, RW_HEAD_DIM), 0.1),
        'rw_ln_w': 1.0 + nrm((NE, RW_WIDTH), 0.02),
        'rw_ln_b': nrm((NE, RW_WIDTH), 0.02),
        'hy_conv_w': nrm((NE, SHORT_CONV, HY_COLS), SHORT_CONV ** -0.5),
        'hy_conv_b': nrm((NE, HY_COLS), 0.02),
        'hy_f_w1': nrm((NE, HY_EMB, HY_ORDER), HY_EMB ** -0.5),
        'hy_f_b1': nrm((NE, HY_ORDER), 0.1),
        'hy_f_w2': nrm((NE, HY_ORDER, HY_ORDER), HY_ORDER ** -0.5),
        'hy_f_b2': nrm((NE, HY_ORDER), 0.1),
        'hy_f_w3': nrm((NE, HY_ORDER, HY_ORDER), HY_ORDER ** -0.5),
        'hy_f_b3': nrm((NE, HY_ORDER), 0.1),
        'hy_f_w4': nrm((NE, HY_ORDER, 2 * HY_WIDTH), HY_ORDER ** -0.5),
        'hy_freq': 1.0 + nrm((NE, HY_ORDER), 0.02),
        'hy_skip': nrm((NE, HY_WIDTH)),
        'dn_w_in': nrm((NO, D, DN_COLS), D ** -0.5),
        'dn_conv_w': nrm((NO, SHORT_CONV, 3 * DN_DIM), SHORT_CONV ** -0.5),
        'dn_A_log': jnp.log(uni((NO, 2, DN_HEADS), 1.0, 16.0)),
        'dn_dt_bias': dt + jnp.log(-jnp.expm1(-dt)),
        'dn_norm': 1.0 + nrm((NO, DN_HEAD_DIM), 0.02),
        'dn_w_out': nrm((NO, DN_DIM, D), DN_DIM ** -0.5),
    }


def reference(x, c, ctx, c_ctx, ada_w, ada_b, norm_mix, norm_mlp, mlp_w1, mlp_w2, final_norm,
              ab_w_in, ab_w_out, rw_mu, rw_w0, rw_w_up, rw_a0, rw_a_up, rw_g_up, rw_k_k, rw_k_a,
              rw_r_k, rw_ln_w, rw_ln_b, hy_conv_w, hy_conv_b, hy_f_w1, hy_f_b1, hy_f_w2, hy_f_b2,
              hy_f_w3, hy_f_b3, hy_f_w4, hy_freq, hy_skip, dn_w_in, dn_conv_w, dn_A_log, dn_dt_bias,
              dn_norm, dn_w_out):
    rows = x.shape[1] // GRID_W
    assert rows * GRID_W == x.shape[1]
    x_lat, x_ctx = x, ctx
    for l in range(DEPTH):
        last = l == DEPTH - 1
        mod_lat = jax.nn.silu(c) @ ada_w[l] + ada_b[l]
        mod_ctx = jax.nn.silu(c_ctx) @ ada_w[l] + ada_b[l]
        ml = jnp.split(mod_lat[:, None, :], ADA_CHUNKS, axis=-1)
        mc = jnp.split(mod_ctx, ADA_CHUNKS, axis=-1)
        h_lat = modulate(rmsnorm(x_lat, norm_mix[l]), ml[0], ml[1])
        h_ctx = modulate(rmsnorm(x_ctx, norm_mix[l]), mc[0], mc[1])
        if l % 2 == 0:
            e = l // 2
            y_ctx, y_lat = rwkv_hyena_mixer(
                h_ctx, h_lat, ab_w_in[e], ab_w_out[e],
                (rw_mu[e], rw_w0[e], rw_w_up[e], rw_a0[e], rw_a_up[e], rw_g_up[e], rw_k_k[e], rw_k_a[e]),
                (rw_r_k[e], rw_ln_w[e], rw_ln_b[e]),
                (hy_conv_w[e], hy_conv_b[e], hy_skip[e]),
                (hy_f_w1[e], hy_f_b1[e], hy_f_w2[e], hy_f_b2[e], hy_f_w3[e], hy_f_b3[e], hy_f_w4[e], hy_freq[e]),
                with_ctx_out=not last)
        else:
            o = l // 2
            y_ctx, y_lat = deltanet_mixer(h_ctx, h_lat, dn_w_in[o], dn_conv_w[o], dn_A_log[o], dn_dt_bias[o],
                                          dn_norm[o], dn_w_out[o], with_ctx_out=not last)
        x_lat = x_lat + ml[2] * y_lat
        x_lat = x_lat + ml[5] * sq_relu_mlp(modulate(rmsnorm(x_lat, norm_mlp[l]), ml[3], ml[4]), mlp_w1[l], mlp_w2[l])
        if not last:
            x_ctx = x_ctx + mc[2] * y_ctx
            x_ctx = x_ctx + mc[5] * sq_relu_mlp(modulate(rmsnorm(x_ctx, norm_mlp[l]), mc[3], mc[4]), mlp_w1[l], mlp_w2[l])
    return rmsnorm(x_lat, final_norm)
```

```cpp
#include <hip/hip_runtime.h>
#include <hip/hip_cooperative_groups.h>
#include <stdint.h>
#include <stdio.h>
namespace cg = cooperative_groups;

typedef unsigned short u16;
typedef __attribute__((ext_vector_type(8))) short bf16x8;
typedef __attribute__((ext_vector_type(4))) float f32x4;

#define NTHR 256
#define MLAT 16384
#define MCTX 2048
#define MTOT 18432
#define LDS_BYTES 73728

constexpr size_t W_IN = 0, W_OUT = 8650752, W_1 = 10747904, W_2 = 19136512, SZ_W = 27525120;
constexpr size_t OFF_SMALL = SZ_W;
constexpr size_t S_MODV = 0;
constexpr size_t S_RNORM = 458752;
constexpr size_t S_BONUS = S_RNORM + 589824;
constexpr size_t S_H3 = S_BONUS + 589824;
constexpr size_t S_HNORM = S_H3 + 589824;
constexpr size_t S_EG = S_HNORM + 4096;
constexpr size_t S_BETA = S_EG + 1179648;
constexpr size_t S_PAB = S_BETA + 1179648;
constexpr size_t S_BAR = 6951936;
constexpr size_t SZ_SMALL = 8388608;
static_assert(S_PAB + 2359296 <= SZ_SMALL, "small");
constexpr size_t OFF_XCTX = OFF_SMALL + SZ_SMALL;
constexpr size_t OFF_A1 = OFF_XCTX + 8388608;
constexpr size_t OFF_FILT = OFF_A1;
constexpr size_t OFF_FILTC = OFF_FILT + 8388608;
constexpr size_t OFF_A0 = OFF_FILT + 9437184;
constexpr size_t SZ_T512 = (size_t)MTOT * 512 * 2;
constexpr size_t L0_H = OFF_A0;
constexpr size_t L0_PRW = L0_H + (size_t)MTOT * 1024 * 2;
constexpr size_t L0_PHY = L0_PRW + (size_t)MTOT * 1792 * 2;
constexpr size_t L0_S = L0_PHY + (size_t)MTOT * 1536 * 2;
constexpr size_t L0_X0C = L0_S + SZ_T512;
constexpr size_t L0_OM1 = L0_H, L0_G = L0_H + SZ_T512;
constexpr size_t L0_LR = L0_X0C + SZ_T512;
static_assert(L0_LR + (size_t)MTOT * 256 * 2 <= 268435456, "ws");
constexpr size_t W_LRW = W_IN + 6815744, W_LRA = W_LRW + 131072, W_LRG = W_LRA + 131072;
constexpr size_t L0_Y0 = L0_PHY, L0_Y1 = L0_PHY + SZ_T512, L0_HY = L0_PHY + 2 * SZ_T512;
constexpr size_t L0_U = L0_PRW;
static_assert(L0_X0C + SZ_T512 <= 268435456, "ws");
static_assert(L0_U + (size_t)MTOT * 4096 * 2 <= 268435456, "ws");
constexpr size_t DO_A0 = 0, DO_A1 = SZ_T512, DO_OM0 = 2 * SZ_T512;
constexpr size_t L1_H = OFF_A1;
constexpr size_t L1_PQKV = L1_H + (size_t)MTOT * 1024 * 2;
constexpr size_t L1_PZ = L1_PQKV + (size_t)MTOT * 3072 * 2;
constexpr size_t L1_O1 = L1_PZ + (size_t)MTOT * 1024 * 2;
constexpr size_t L1_O0 = L1_H;
constexpr size_t L1_U = L1_PQKV;
static_assert(L1_O1 + (size_t)MLAT * 1024 * 2 <= 268435456, "ws");
constexpr size_t WS_NEED = 268435456;

struct Params { const float* in[41]; float* out; unsigned char* ws; };
typedef const __attribute__((address_space(4))) Params* CP;
__device__ __forceinline__ CP launder(CP p) { asm volatile("" : "+s"(p)); return p; }

enum { I_X = 0, I_C, I_CTX, I_CCTX, I_ADAW, I_ADAB, I_NMIX, I_NMLP, I_W1, I_W2, I_FNORM, I_ABIN, I_ABOUT, I_MU, I_RW0, I_WUP,
       I_A0, I_AUP, I_GUP, I_KK, I_KA, I_RK, I_LNW, I_LNB, I_HCW, I_HCB, I_FW1, I_FB1, I_FW2, I_FB2, I_FW3, I_FB3, I_FW4,
       I_FREQ, I_SKIP, I_DNIN, I_DNCW, I_DNALOG, I_DNDT, I_DNNORM, I_DNOUT };

__device__ __forceinline__ u16 f2bf(float f) { unsigned u = __float_as_uint(f); u += 0x7fffu + ((u >> 16) & 1u); return (u16)(u >> 16); }
__device__ __forceinline__ float bf2f(u16 h) { return __uint_as_float(((unsigned)h) << 16); }
__device__ __forceinline__ unsigned pack2(float a, float b) { return (unsigned)f2bf(a) | ((unsigned)f2bf(b) << 16); }
__device__ __forceinline__ float sigmoidf_(float x) { return 1.f / (1.f + __expf(-x)); }
__device__ __forceinline__ float siluf_(float x) { return x / (1.f + __expf(-x)); }
__device__ __forceinline__ float softplusf_(float x) { return fmaxf(x, 0.f) + log1pf(__expf(-fabsf(x))); }
__device__ __forceinline__ float wave_sum(float v) {
  v += __int_as_float(__builtin_amdgcn_mov_dpp(__float_as_int(v), 0xB1, 0xF, 0xF, true));
  v += __int_as_float(__builtin_amdgcn_mov_dpp(__float_as_int(v), 0x4E, 0xF, 0xF, true));
  v += __int_as_float(__builtin_amdgcn_mov_dpp(__float_as_int(v), 0x141, 0xF, 0xF, true));
  v += __int_as_float(__builtin_amdgcn_mov_dpp(__float_as_int(v), 0x140, 0xF, 0xF, true));
  float a = __int_as_float(__builtin_amdgcn_readlane(__float_as_int(v), 0)), b = __int_as_float(__builtin_amdgcn_readlane(__float_as_int(v), 16));
  float c = __int_as_float(__builtin_amdgcn_readlane(__float_as_int(v), 32)), d = __int_as_float(__builtin_amdgcn_readlane(__float_as_int(v), 48));
  return (a + b) + (c + d);
}
typedef float v2f __attribute__((ext_vector_type(2)));
__device__ __forceinline__ float red8(float v) {
  v += __int_as_float(__builtin_amdgcn_mov_dpp(__float_as_int(v), 0xB1, 0xF, 0xF, true));
  v += __int_as_float(__builtin_amdgcn_mov_dpp(__float_as_int(v), 0x4E, 0xF, 0xF, true));
  v += __int_as_float(__builtin_amdgcn_mov_dpp(__float_as_int(v), 0x141, 0xF, 0xF, true));
  return v;
}
__device__ __forceinline__ float red16(float v) {
  v = red8(v);
  v += __int_as_float(__builtin_amdgcn_mov_dpp(__float_as_int(v), 0x140, 0xF, 0xF, true));
  return v;
}

#define RED16S(v) do { v += DPPF(v, 0xB1); v += DPPF(v, 0x4E); v += DPPF(v, 0x141); v += DPPF(v, 0x140); } while (0)
#define DPPF(v, ctrl) __int_as_float(__builtin_amdgcn_mov_dpp(__float_as_int(v), ctrl, 0xF, 0xF, true))
__device__ __forceinline__ void red16x2(v2f& a, v2f& b) {
  { v2f ta, tb; ta.x = DPPF(a.x, 0xB1); ta.y = DPPF(a.y, 0xB1); tb.x = DPPF(b.x, 0xB1); tb.y = DPPF(b.y, 0xB1); a += ta; b += tb; }
  { v2f ta, tb; ta.x = DPPF(a.x, 0x4E); ta.y = DPPF(a.y, 0x4E); tb.x = DPPF(b.x, 0x4E); tb.y = DPPF(b.y, 0x4E); a += ta; b += tb; }
  { v2f ta, tb; ta.x = DPPF(a.x, 0x141); ta.y = DPPF(a.y, 0x141); tb.x = DPPF(b.x, 0x141); tb.y = DPPF(b.y, 0x141); a += ta; b += tb; }
  { v2f ta, tb; ta.x = DPPF(a.x, 0x140); ta.y = DPPF(a.y, 0x140); tb.x = DPPF(b.x, 0x140); tb.y = DPPF(b.y, 0x140); a += ta; b += tb; }
}

#define XB_TMO      128
#define XB_XCNT(j)  (256  + 64 * (j))
#define XB_XSUB(j)  (1280 + 64 * (j))
#define XB_XGEN(j)  (2304 + 64 * (j))
#define XB_TOP      3328
#define XB_TOPGEN   3392
#define XCD_BAR_WORDS 3456
#define XB_SPIN_CAP (1u << 18)
#define LAS __attribute__((address_space(3)))

__device__ __forceinline__ unsigned xb_ld(unsigned* p)              { return __hip_atomic_load(p, __ATOMIC_RELAXED, __HIP_MEMORY_SCOPE_AGENT); }
__device__ __forceinline__ unsigned xb_add(unsigned* p, unsigned v) { return __hip_atomic_fetch_add(p, v, __ATOMIC_RELAXED, __HIP_MEMORY_SCOPE_AGENT); }
__device__ __forceinline__ unsigned xb_xcc_id() { return (unsigned)__builtin_amdgcn_s_getreg((3 << 11) | 20) & 0xFu; }
#define XB_SPIN(cond, bar) do { unsigned _sp = 0; while (cond) { __builtin_amdgcn_s_sleep(1); \
    if ((++_sp & 255u) == 0u) { if (xb_ld(&(bar)[XB_TMO])) break; if (_sp > XB_SPIN_CAP) { atomicAdd(&(bar)[XB_TMO], 1u); break; } } } } while (0)

struct XcdBarrier {
    unsigned* bar; unsigned x;
    volatile LAS unsigned* st;
};

__device__ __forceinline__ XcdBarrier xcd_barrier_post(unsigned* bar, volatile LAS unsigned* st) {
    XcdBarrier b; b.bar = bar; b.x = xb_xcc_id(); b.st = st;
    if (threadIdx.x == 0) (void)xb_add(&bar[XB_XCNT(b.x)], 1u);
    return b;
}
__device__ __forceinline__ void xcd_barrier_complete(unsigned* bar, unsigned x, unsigned& nloc, unsigned& nx) {
    const unsigned G = gridDim.x * gridDim.y * gridDim.z;
    unsigned sum, cnt, mine, sp = 0u;
    for (;;) {
        sum = 0u; cnt = 0u; mine = 0u;
#pragma unroll
        for (unsigned j = 0; j < 16; ++j) { const unsigned c = xb_ld(&bar[XB_XCNT(j)]); sum += c; cnt += (c > 0u) ? 1u : 0u; mine = (j == x) ? c : mine; }
        if (sum == G) break;
        __builtin_amdgcn_s_sleep(1);
        if ((++sp & 255u) == 0u) { if (xb_ld(&bar[XB_TMO])) break; if (sp > XB_SPIN_CAP) { atomicAdd(&bar[XB_TMO], 1u); break; } }
    }
    nloc = mine > 0u ? mine : 1u; nx = cnt > 0u ? cnt : 1u;
}

__device__ __forceinline__ void xcd_barrier(const XcdBarrier& b) {
    asm volatile("s_waitcnt vmcnt(0)" ::: "memory");
    __syncthreads();
    if (threadIdx.x == 0) {
        unsigned* bar = b.bar;
        __builtin_amdgcn_s_waitcnt(0);
        unsigned nloc = b.st[0], nx = b.st[1];
        if (nloc == 0u) { xcd_barrier_complete(bar, b.x, nloc, nx); b.st[0] = nloc; b.st[1] = nx; }
        const unsigned old = xb_add(&bar[XB_XSUB(b.x)], 1u);
        const unsigned gen = old / nloc;
        if (old + 1u == (gen + 1u) * nloc) {
            __builtin_amdgcn_fence(__ATOMIC_RELEASE, "agent");
            asm volatile("s_waitcnt vmcnt(0)" ::: "memory");
            const unsigned og = xb_add(&bar[XB_TOP], 1u);
            const unsigned tg = og / nx;
            if (og + 1u == (tg + 1u) * nx) xb_add(&bar[XB_TOPGEN], 1u);
            else XB_SPIN(xb_ld(&bar[XB_TOPGEN]) == tg, bar);
            __builtin_amdgcn_fence(__ATOMIC_ACQUIRE, "agent");
            xb_add(&bar[XB_XGEN(b.x)], 1u);
            asm volatile("s_waitcnt vmcnt(0)" ::: "memory");
        } else {
            XB_SPIN(xb_ld(&bar[XB_XGEN(b.x)]) == gen, bar);
            __builtin_amdgcn_fence(__ATOMIC_ACQUIRE, "agent");
            asm volatile("s_waitcnt vmcnt(0)" ::: "memory");
        }
    }
    __syncthreads();
}


__device__ __forceinline__ float fma_s(float a, float b, float c) { float d; asm("v_fma_f32 %0, %1, %2, %3" : "=v"(d) : "v"(a), "v"(b), "v"(c)); return d; }
__device__ __forceinline__ float mul_s(float a, float b) { float d; asm("v_mul_f32 %0, %1, %2" : "=v"(d) : "v"(a), "v"(b)); return d; }
__device__ __forceinline__ void red16q(float& a, float& b, float& c, float& d) {
  asm("s_nop 1\n\t"
      "v_add_f32_dpp %0, %0, %0 quad_perm:[1,0,3,2] row_mask:0xf bank_mask:0xf bound_ctrl:1\n\t"
      "v_add_f32_dpp %1, %1, %1 quad_perm:[1,0,3,2] row_mask:0xf bank_mask:0xf bound_ctrl:1\n\t"
      "v_add_f32_dpp %2, %2, %2 quad_perm:[1,0,3,2] row_mask:0xf bank_mask:0xf bound_ctrl:1\n\t"
      "v_add_f32_dpp %3, %3, %3 quad_perm:[1,0,3,2] row_mask:0xf bank_mask:0xf bound_ctrl:1\n\t"
      "v_add_f32_dpp %0, %0, %0 quad_perm:[2,3,0,1] row_mask:0xf bank_mask:0xf bound_ctrl:1\n\t"
      "v_add_f32_dpp %1, %1, %1 quad_perm:[2,3,0,1] row_mask:0xf bank_mask:0xf bound_ctrl:1\n\t"
      "v_add_f32_dpp %2, %2, %2 quad_perm:[2,3,0,1] row_mask:0xf bank_mask:0xf bound_ctrl:1\n\t"
      "v_add_f32_dpp %3, %3, %3 quad_perm:[2,3,0,1] row_mask:0xf bank_mask:0xf bound_ctrl:1\n\t"
      "v_add_f32_dpp %0, %0, %0 row_half_mirror row_mask:0xf bank_mask:0xf bound_ctrl:1\n\t"
      "v_add_f32_dpp %1, %1, %1 row_half_mirror row_mask:0xf bank_mask:0xf bound_ctrl:1\n\t"
      "v_add_f32_dpp %2, %2, %2 row_half_mirror row_mask:0xf bank_mask:0xf bound_ctrl:1\n\t"
      "v_add_f32_dpp %3, %3, %3 row_half_mirror row_mask:0xf bank_mask:0xf bound_ctrl:1\n\t"
      "v_add_f32_dpp %0, %0, %0 row_mirror row_mask:0xf bank_mask:0xf bound_ctrl:1\n\t"
      "v_add_f32_dpp %1, %1, %1 row_mirror row_mask:0xf bank_mask:0xf bound_ctrl:1\n\t"
      "v_add_f32_dpp %2, %2, %2 row_mirror row_mask:0xf bank_mask:0xf bound_ctrl:1\n\t"
      "v_add_f32_dpp %3, %3, %3 row_mirror row_mask:0xf bank_mask:0xf bound_ctrl:1\n\t"
      "s_nop 1"
      : "+v"(a), "+v"(b), "+v"(c), "+v"(d));
}

__device__ __forceinline__ void red8d(float& a, float& b) {
  asm("s_nop 1\n\t"
      "v_add_f32_dpp %0, %0, %0 quad_perm:[1,0,3,2] row_mask:0xf bank_mask:0xf bound_ctrl:1\n\t"
      "v_add_f32_dpp %1, %1, %1 quad_perm:[1,0,3,2] row_mask:0xf bank_mask:0xf bound_ctrl:1\n\t"
      "s_nop 0\n\t"
      "v_add_f32_dpp %0, %0, %0 quad_perm:[2,3,0,1] row_mask:0xf bank_mask:0xf bound_ctrl:1\n\t"
      "v_add_f32_dpp %1, %1, %1 quad_perm:[2,3,0,1] row_mask:0xf bank_mask:0xf bound_ctrl:1\n\t"
      "s_nop 0\n\t"
      "v_add_f32_dpp %0, %0, %0 row_half_mirror row_mask:0xf bank_mask:0xf bound_ctrl:1\n\t"
      "v_add_f32_dpp %1, %1, %1 row_half_mirror row_mask:0xf bank_mask:0xf bound_ctrl:1\n\t"
      "s_nop 0"
      : "+v"(a), "+v"(b));
}

__device__ __forceinline__ void lds_barrier() {
  asm volatile("s_waitcnt lgkmcnt(0)" ::: "memory");
  __builtin_amdgcn_s_barrier();
  asm volatile("" ::: "memory");
}

#define LDSROW 64
struct ASrc { const u16* p1; int ld1; const u16* p2; int ld2; int ksplit; };

template <class Epi>
__device__ __forceinline__ void gemm_phase(unsigned char* smem_raw, ASrc a, const u16* __restrict__ Bt, int M, int N, int K, Epi epi) {
  u16* sA = (u16*)smem_raw;
  u16* sB = sA + 2 * 128 * LDSROW;
  const int tid = threadIdx.x, lane = tid & 63, wid = tid >> 6;
  const int wr = wid >> 1, wc = wid & 1, fr = lane & 15, fq = lane >> 4;
  const int Mt = M / 128, Nt = N / 128, nk = K / 64;
  const int lrow = tid >> 3, lkc = tid & 7;
  const int wsw = lkc ^ ((lrow >> 1) & 7);
  const int rsw = fq ^ (fr >> 1);
  const int nx = (gridDim.x & 7) ? 1 : 8;
  const int xcd = (nx == 8) ? (blockIdx.x & 7) : 0, lb = (nx == 8) ? (blockIdx.x >> 3) : blockIdx.x, lstep = gridDim.x / nx;
  const int tm0 = (Mt * xcd) / nx, mh = (Mt * (xcd + 1)) / nx - tm0;
  for (int tl = lb; tl < mh * Nt; tl += lstep) {
    const int pn = tl / (mh * 8), rem = tl - pn * (mh * 8);
    const int wp = min(8, Nt - pn * 8);
    const int tm = tm0 + rem / wp, tn = pn * 8 + rem % wp;
    f32x4 acc[4][4];
#pragma unroll
    for (int i = 0; i < 4; ++i)
#pragma unroll
      for (int j = 0; j < 4; ++j) acc[i][j] = (f32x4){0.f, 0.f, 0.f, 0.f};
    auto gissue = [&](int kt, int buf) {
      const int k0 = kt * 64;
      const u16* ap; int lda;
      if (k0 < a.ksplit) { ap = a.p1 + k0; lda = a.ld1; } else { ap = a.p2 + (k0 - a.ksplit); lda = a.ld2; }
#pragma unroll
      for (int i = 0; i < 4; ++i) {
        const int r = lrow + i * 32;
        __builtin_amdgcn_global_load_lds((const unsigned*)(ap + (size_t)(tm * 128 + r) * lda + wsw * 8),
                                         (LAS unsigned*)(sA + buf * 128 * LDSROW + r * LDSROW + lkc * 8), 16, 0, 0);
        __builtin_amdgcn_global_load_lds((const unsigned*)(Bt + (size_t)(tn * 128 + r) * K + k0 + wsw * 8),
                                         (LAS unsigned*)(sB + buf * 128 * LDSROW + r * LDSROW + lkc * 8), 16, 0, 0);
      }
    };
    gissue(0, 0);
    asm volatile("s_waitcnt vmcnt(0)" ::: "memory");
    __syncthreads();
    for (int kt = 0; kt < nk; ++kt) {
      const int buf = kt & 1;
      if (kt + 1 < nk) gissue(kt + 1, buf ^ 1);
      const u16* pa = sA + buf * 128 * LDSROW + (wr * 64 + fr) * LDSROW;
      const u16* pb = sB + buf * 128 * LDSROW + (wc * 64 + fr) * LDSROW;
      bf16x8 af[2][4], bfr[2][4];
#pragma unroll
      for (int ks = 0; ks < 2; ++ks)
#pragma unroll
        for (int i = 0; i < 4; ++i) {
          af[ks][i] = *(const bf16x8*)(pa + i * 16 * LDSROW + ((rsw ^ (ks * 4)) * 8));
          bfr[ks][i] = *(const bf16x8*)(pb + i * 16 * LDSROW + ((rsw ^ (ks * 4)) * 8));
        }
      __builtin_amdgcn_s_setprio(1);
#pragma unroll
      for (int ks = 0; ks < 2; ++ks)
#pragma unroll
        for (int i = 0; i < 4; ++i)
#pragma unroll
          for (int j = 0; j < 4; ++j)
            acc[i][j] = __builtin_amdgcn_mfma_f32_16x16x32_bf16(bfr[ks][j], af[ks][i], acc[i][j], 0, 0, 0);
      __builtin_amdgcn_s_setprio(0);
      asm volatile("s_waitcnt vmcnt(0)" ::: "memory");
      __syncthreads();
    }
#pragma unroll
    for (int i = 0; i < 4; ++i)
#pragma unroll
      for (int j = 0; j < 4; ++j)
        epi(tm * 128 + wr * 64 + i * 16 + fr, tn * 128 + wc * 64 + j * 16 + fq * 4, acc[i][j]);
  }
}

struct EpiInProj0 {
  u16* prw; u16* phy;
  __device__ __forceinline__ void operator()(int row, int col, f32x4 v) const {
    uint2 pk = make_uint2(pack2(v[0], v[1]), pack2(v[2], v[3]));
    if (col < 1792) *(uint2*)(prw + (size_t)row * 1792 + col) = pk;
    else *(uint2*)(phy + (size_t)row * 1536 + (col - 1792)) = pk;
  }
};
struct EpiInProj1 {
  u16* pqkv; u16* pz; float* pab; u16* halo;
  __device__ __forceinline__ void operator()(int row, int col, f32x4 v) const {
    if (col < 4096) {
      uint2 pk = make_uint2(pack2(v[0], v[1]), pack2(v[2], v[3]));
      if (col < 3072) {
        *(uint2*)(pqkv + (size_t)row * 3072 + col) = pk;
        const int rl = row & 127;
        if (rl == 0 || rl == 127) *(uint2*)(halo + (size_t)((row >> 7) * 2 + (rl ? 1 : 0)) * 3072 + col) = pk;
      }
      else *(uint2*)(pz + (size_t)row * 1024 + (col - 3072)) = pk;
    } else if (col < 4128) {
      *(float4*)(pab + (size_t)row * 32 + (col - 4096)) = make_float4(v[0], v[1], v[2], v[3]);
    }
  }
};
struct EpiRelu2 {
  u16* u;
  __device__ __forceinline__ void operator()(int row, int col, f32x4 v) const {
    float a = fmaxf(v[0], 0.f), b = fmaxf(v[1], 0.f), c = fmaxf(v[2], 0.f), d = fmaxf(v[3], 0.f);
    *(uint2*)(u + (size_t)row * 4096 + col) = make_uint2(pack2(a * a, b * b), pack2(c * c, d * d));
  }
};
struct EpiResid {
  const float* xin_lat; const float* xin_ctx; float* xout_lat; float* xout_ctx; const float* modv;
  __device__ __forceinline__ void operator()(int row, int col, f32x4 v) const {
    const float* xi; float* xo; int mr;
    if (row < MLAT) { mr = row >> 11; xi = xin_lat + (size_t)row * 1024; xo = xout_lat + (size_t)row * 1024; }
    else { mr = 8; xi = xin_ctx + (size_t)(row - MLAT) * 1024; xo = xout_ctx + (size_t)(row - MLAT) * 1024; }
    float4 x = *(const float4*)(xi + col);
    float4 m = *(const float4*)(modv + mr * 6144 + col);
    *(float4*)(xo + col) = make_float4(x.x + m.x * v[0], x.y + m.y * v[1], x.z + m.z * v[2], x.w + m.w * v[3]);
  }
};

__device__ __forceinline__ void norm_phase(const float* xlat, const float* xctx, int nrows, const float* nw, const float* modl, int shiftc, int scalec, u16* h) {
  const int lane = threadIdx.x & 63, wid = threadIdx.x >> 6;
  for (int row = blockIdx.x * 4 + wid; row < nrows; row += gridDim.x * 4) {
    const float* src; int mr;
    if (row < MLAT) { src = xlat + (size_t)row * 1024; mr = row >> 11; } else { src = xctx + (size_t)(row - MLAT) * 1024; mr = 8; }
    float4 v[4]; float ss = 0.f;
#pragma unroll
    for (int i = 0; i < 4; ++i) { v[i] = *(const float4*)(src + (i * 64 + lane) * 4); ss += v[i].x * v[i].x + v[i].y * v[i].y + v[i].z * v[i].z + v[i].w * v[i].w; }
    ss = wave_sum(ss);
    const float rs = rsqrtf(ss * (1.f / 1024.f) + 1e-6f);
    const float* sh = modl + mr * 6144 + shiftc * 1024; const float* sc = modl + mr * 6144 + scalec * 1024;
#pragma unroll
    for (int i = 0; i < 4; ++i) {
      int c = (i * 64 + lane) * 4;
      float4 w = *(const float4*)(nw + c), s = *(const float4*)(sh + c), g = *(const float4*)(sc + c);
      float a = v[i].x * rs * w.x * (1.f + g.x) + s.x, b = v[i].y * rs * w.y * (1.f + g.y) + s.y;
      float cc = v[i].z * rs * w.z * (1.f + g.z) + s.z, d = v[i].w * rs * w.w * (1.f + g.w) + s.w;
      *(uint2*)(h + (size_t)row * 1024 + c) = make_uint2(pack2(a, b), pack2(cc, d));
    }
  }
}

__device__ __forceinline__ void wconv_item(float* tile  , const float* __restrict__ src, int K, int N, int Npad, u16* dst, int item) {
  const int tid = threadIdx.x;
  const int ntn = Npad / 64;
  const int tk = item / ntn, tn = item % ntn;
#pragma unroll
  for (int i = 0; i < 16; ++i) {
    int k = i * 4 + (tid >> 6), n = tid & 63;
    int gn = tn * 64 + n;
    tile[k * 65 + n] = (gn < N) ? src[(size_t)(tk * 64 + k) * N + gn] : 0.f;
  }
  __syncthreads();
#pragma unroll
  for (int i = 0; i < 2; ++i) {
    int c = tid + i * 256, n = c >> 3, kg = c & 7;
    unsigned p[4];
#pragma unroll
    for (int j = 0; j < 4; ++j) p[j] = pack2(tile[(kg * 8 + 2 * j) * 65 + n], tile[(kg * 8 + 2 * j + 1) * 65 + n]);
    *(uint4*)(dst + (size_t)(tn * 64 + n) * K + tk * 64 + kg * 8) = make_uint4(p[0], p[1], p[2], p[3]);
  }
  __syncthreads();
}
__device__ __forceinline__ void wconv_layer(float* tile, CP P, int layer, int gstart, int gstride) {
  unsigned char* ws = P->ws;
  const float* s_in; int n_in, np_in; const float* s_out;
  if (layer == 0) { s_in = P->in[I_ABIN]; n_in = 3328; np_in = 3328; s_out = P->in[I_ABOUT]; }
  else { s_in = P->in[I_DNIN]; n_in = 4128; np_in = 4224; s_out = P->in[I_DNOUT]; }
  const float* s_w1 = P->in[I_W1] + (size_t)layer * 1024 * 4096;
  const float* s_w2 = P->in[I_W2] + (size_t)layer * 4096 * 1024;
  const int n0 = 16 * (np_in / 64), n1 = 16 * 16, n2 = 16 * 64, n3 = 64 * 16;
  const int n4 = (layer == 0) ? 48 : 0;
  for (int it = gstart; it < n0 + n1 + n2 + n3 + n4; it += gstride) {
    if (it >= n0 + n1 + n2 + n3) {
      const int q = it - (n0 + n1 + n2 + n3);
      if (q < 16) wconv_item(tile, P->in[I_WUP] + (size_t)(q >> 3) * 64 * 512, 64, 512, 512, (u16*)(ws + W_LRW) + (size_t)(q >> 3) * 512 * 64, q & 7);
      else if (q < 32) wconv_item(tile, P->in[I_AUP] + (size_t)((q - 16) >> 3) * 64 * 512, 64, 512, 512, (u16*)(ws + W_LRA) + (size_t)((q - 16) >> 3) * 512 * 64, q & 7);
      else wconv_item(tile, P->in[I_GUP], 128, 512, 512, (u16*)(ws + W_LRG), q - 32);
    }
    else if (it < n0) wconv_item(tile, s_in, 1024, n_in, np_in, (u16*)(ws + W_IN), it);
    else if (it < n0 + n1) wconv_item(tile, s_out, 1024, 1024, 1024, (u16*)(ws + W_OUT), it - n0);
    else if (it < n0 + n1 + n2) wconv_item(tile, s_w1, 1024, 4096, 4096, (u16*)(ws + W_1), it - n0 - n1);
    else wconv_item(tile, s_w2, 4096, 1024, 1024, (u16*)(ws + W_2), it - n0 - n1 - n2);
  }
}

__device__ __forceinline__ void modv_item(float* lds, CP P, int item) {
  const int tid = threadIdx.x;
  const int l = item / 192, n0 = (item % 192) * 32;
  float* sc = lds;
  float* red = lds + 9 * 1024;
  for (int e = tid; e < 9 * 1024; e += NTHR) {
    int r = e >> 10, k = e & 1023;
    float cv = (r < 8) ? P->in[I_C][r * 1024 + k] : P->in[I_CCTX][k];
    sc[e] = siluf_(cv);
  }
  __syncthreads();
  const int col = tid & 31, kp = tid >> 5;
  const float* w = P->in[I_ADAW] + (size_t)l * 1024 * 6144 + n0 + col;
  float acc[9];
#pragma unroll
  for (int r = 0; r < 9; ++r) acc[r] = 0.f;
#pragma unroll 4
  for (int k = kp * 128; k < kp * 128 + 128; k += 4) {
    float w0 = w[(size_t)k * 6144], w1 = w[(size_t)(k + 1) * 6144], w2 = w[(size_t)(k + 2) * 6144], w3 = w[(size_t)(k + 3) * 6144];
#pragma unroll
    for (int r = 0; r < 9; ++r) {
      float4 s = *(const float4*)(sc + r * 1024 + k);
      acc[r] += s.x * w0 + s.y * w1 + s.z * w2 + s.w * w3;
    }
  }
#pragma unroll
  for (int r = 0; r < 9; ++r) red[(kp * 9 + r) * 32 + col] = acc[r];
  __syncthreads();
  float* modv = (float*)(P->ws + OFF_SMALL + S_MODV);
  for (int e = tid; e < 9 * 32; e += NTHR) {
    int r = e >> 5, c = e & 31;
    float s = 0.f;
#pragma unroll
    for (int q = 0; q < 8; ++q) s += red[(q * 9 + r) * 32 + c];
    modv[(size_t)l * 9 * 6144 + r * 6144 + n0 + c] = s + P->in[I_ADAB][l * 6144 + n0 + c];
  }
  __syncthreads();
}

__device__ __forceinline__ void h3_item(float* lds, CP P, int item) {
  const int tid = threadIdx.x, p = tid >> 6, j = tid & 63;
  int L, pos, obase;
  if (item < 512) { L = 2048; pos = item * 4 + p; obase = 0; } else { L = 256; pos = (item - 512) * 4 + p; obase = 2048; }
  float* z = lds;
  float* ha = lds + 256;
  float* hb = lds + 512;
  if (j < 33) {
    float val;
    if (j == 0) val = (float)pos / (float)(L - 1);
    else {
      int bi = (j - 1) & 15;
      float f = 1e-4f + (float)bi * ((15.f - 1e-4f) / 15.f);
      float w = 6.283185307179586f * (float)pos / (float)L;
      float ang = f * w;
      val = (j <= 16) ? cosf(ang) : -sinf(ang);
    }
    z[p * 64 + j] = val;
  }
  __syncthreads();
  const float fq = P->in[I_FREQ][j];
  {
    float s = P->in[I_FB1][j];

#pragma unroll 4
    for (int i = 0; i < 33; ++i) s += z[p * 64 + i] * P->in[I_FW1][i * 64 + j];
    ha[p * 64 + j] = sinf(fq * s);
  }
  __syncthreads();
  {
    float s = P->in[I_FB2][j];

#pragma unroll 4
    for (int i = 0; i < 64; ++i) s += ha[p * 64 + i] * P->in[I_FW2][i * 64 + j];
    hb[p * 64 + j] = sinf(fq * s);
  }
  __syncthreads();
  {
    float s = P->in[I_FB3][j];

#pragma unroll 4
    for (int i = 0; i < 64; ++i) s += hb[p * 64 + i] * P->in[I_FW3][i * 64 + j];
    float* H3 = (float*)(P->ws + OFF_SMALL + S_H3);
    H3[(size_t)(obase + pos) * 64 + j] = sinf(fq * s);
  }
  __syncthreads();
}

__device__ __forceinline__ void kun_item(float* lds, CP P, int item) {
  const int tid = threadIdx.x;
  int L, pos0, hbase, seq; float* filt;
  if (item < 256) { L = 2048; pos0 = item * 8; hbase = 0; seq = 0; filt = (float*)(P->ws + OFF_FILT); }
  else { L = 256; pos0 = (item - 256) * 8; hbase = 2048; seq = 1; filt = (float*)(P->ws + OFF_FILTC); }
  const float* H3 = (const float*)(P->ws + OFF_SMALL + S_H3);
  float* hs = lds;
  for (int e = tid; e < 512; e += NTHR) { int p = e >> 6, i = e & 63; hs[i * 8 + p] = H3[(size_t)(hbase + pos0 + p) * 64 + i]; }
  __syncthreads();
  float acc[4][8];
#pragma unroll
  for (int q = 0; q < 4; ++q)
#pragma unroll
    for (int p = 0; p < 8; ++p) acc[q][p] = 0.f;
  const float* w4 = P->in[I_FW4];
  for (int i = 0; i < 64; ++i) {
    float4 h0 = *(const float4*)(hs + i * 8), h1 = *(const float4*)(hs + i * 8 + 4);
#pragma unroll
    for (int q = 0; q < 4; ++q) {
      float w = w4[i * 1024 + tid + q * 256];
      acc[q][0] += h0.x * w; acc[q][1] += h0.y * w; acc[q][2] += h0.z * w; acc[q][3] += h0.w * w;
      acc[q][4] += h1.x * w; acc[q][5] += h1.y * w; acc[q][6] += h1.z * w; acc[q][7] += h1.w * w;
    }
  }
  float* hnorm = (float*)(P->ws + OFF_SMALL + S_HNORM);
  const float lo = -3.0701134573253945f, hi = -15.350567286626973f;
#pragma unroll
  for (int q = 0; q < 4; ++q) {
    int col = tid + q * 256, half = col >> 9, c = col & 511;
    float delta = fabsf(lo + (hi - lo) * ((float)c / 511.f));
    float asum = 0.f;
#pragma unroll
    for (int p = 0; p < 8; ++p) {
      int j = pos0 + p;
      float t = (float)j / (float)(L - 1);
      float val = acc[q][p] * __expf(-t * delta);
      if (half == 0) { filt[(size_t)c * (2 * L) + (j + L - 1)] = val; asum += fabsf(val); }
      else if (j >= 1) { filt[(size_t)c * (2 * L) + (L - 1 - j)] = val; asum += fabsf(val); }
    }
    atomicAdd(&hnorm[seq * 512 + c], asum);
  }
  __syncthreads();
}

__device__ __forceinline__ void seq_of_row(int row, int& sstart, int& slen) {
  if (row < MLAT) { sstart = row & ~2047; slen = 2048; } else { sstart = MLAT + ((row - MLAT) & ~255); slen = 256; }
}

__device__ __forceinline__ void lrprep_item(CP P, int item) {
  const int tid = threadIdx.x, lane = tid & 63;
  const int row0 = item * 16;
  int sstart, slen; seq_of_row(row0, sstart, slen);
  const int send = sstart + slen;
  unsigned char* ws = P->ws;
  const u16* prw = (const u16*)(ws + L0_PRW);
  u16* LR = (u16*)(ws + L0_LR);
  float* RN = (float*)(ws + OFF_SMALL + S_RNORM);
  {
    const int col = 1536 + tid;
    const float mu = P->in[I_MU][col];
    u16 rv[18];
#pragma unroll
    for (int t = 0; t < 18; ++t) { int rr = row0 - 1 + t; rr = rr < sstart ? sstart : (rr >= send ? send - 1 : rr); rv[t] = prw[(size_t)rr * 1792 + col]; }
#pragma unroll
    for (int t = 0; t < 16; ++t) {
      float prev = (row0 + t - 1 >= sstart) ? bf2f(rv[t]) : 0.f, cur = bf2f(rv[t + 1]), nxt = (row0 + t + 1 < send) ? bf2f(rv[t + 2]) : 0.f;
      float s = cur + mu * (0.5f * (prev + nxt) - cur);
      float o = (tid < 64) ? tanhf(s) : ((tid < 128) ? s : sigmoidf_(s));
      LR[(size_t)(row0 + t) * 256 + tid] = f2bf(o);
    }
  }
#pragma unroll
  for (int jj = 0; jj < 2; ++jj) {
    const int j = tid + jj * 256, head = j >> 6;
    const float muk = P->in[I_MU][512 + j], kkk = P->in[I_KK][j];
    u16 kv[18];
#pragma unroll
    for (int t = 0; t < 18; ++t) { int rr = row0 - 1 + t; rr = rr < sstart ? sstart : (rr >= send ? send - 1 : rr); kv[t] = prw[(size_t)rr * 1792 + 512 + j]; }
#pragma unroll
    for (int t = 0; t < 16; ++t) {
      float kp = (row0 + t - 1 >= sstart) ? bf2f(kv[t]) : 0.f, kc = bf2f(kv[t + 1]), kn = (row0 + t + 1 < send) ? bf2f(kv[t + 2]) : 0.f;
      float ks = kc + muk * (0.5f * (kp + kn) - kc);
      float kq = ks * kkk; kq = wave_sum(kq * kq);
      if (lane == 0) RN[(size_t)(row0 + t) * 8 + head] = rsqrtf(kq + 1e-6f);
    }
  }
}

struct EpiLrW {
  u16* om0; u16* om1; const float* w0;
  __device__ __forceinline__ void operator()(int row, int col, f32x4 v) const {
    float o[4];
#pragma unroll
    for (int e = 0; e < 4; ++e) {
      float z = w0[col + e] + v[e];
      float wlog = -softplusf_(-z) - 0.5f;
      o[e] = -expm1f(-__expf(wlog));
    }
    u16* dst = (col < 512) ? om0 : om1;
    *(uint2*)(dst + (size_t)row * 512 + (col & 511)) = make_uint2(pack2(o[0], o[1]), pack2(o[2], o[3]));
  }
};
struct EpiLrA {
  u16* a0; u16* a1; const float* b0;
  __device__ __forceinline__ void operator()(int row, int col, f32x4 v) const {
    float o[4];
#pragma unroll
    for (int e = 0; e < 4; ++e) o[e] = sigmoidf_(b0[col + e] + v[e]);
    u16* dst = (col < 512) ? a0 : a1;
    *(uint2*)(dst + (size_t)row * 512 + (col & 511)) = make_uint2(pack2(o[0], o[1]), pack2(o[2], o[3]));
  }
};
struct EpiLrG {
  u16* g;
  __device__ __forceinline__ void operator()(int row, int col, f32x4 v) const {
    *(uint2*)(g + (size_t)row * 512 + col) = make_uint2(pack2(v[0], v[1]), pack2(v[2], v[3]));
  }
};

__device__ __forceinline__ void hyprep_item(CP P, int item) {
  const int tid = threadIdx.x;
  const int row0 = item * 16;
  int sstart, slen; seq_of_row(row0, sstart, slen);
  const int send = sstart + slen;
  const u16* phy = (const u16*)(P->ws + L0_PHY);
  u16* S = (u16*)(P->ws + L0_S); u16* X0 = (u16*)(P->ws + L0_X0C);
  const float* cw = P->in[I_HCW]; const float* cb = P->in[I_HCB];
  for (int cc = 0; cc < 2; ++cc) {
    const int c = tid + cc * 256;
    float w[3][3], bsv[3], pv[3], cv[3];
#pragma unroll
    for (int g = 0; g < 3; ++g) {
      int col = g * 512 + c;
      w[g][0] = cw[col]; w[g][1] = cw[1536 + col]; w[g][2] = cw[3072 + col]; bsv[g] = cb[col];
      pv[g] = (row0 - 1 >= sstart) ? bf2f(phy[(size_t)(row0 - 1) * 1536 + col]) : 0.f;
      cv[g] = bf2f(phy[(size_t)row0 * 1536 + col]);
    }
    unsigned sp[8];
#pragma unroll
    for (int t = 0; t < 16; ++t) {
      int rn = row0 + t + 1; float o[3];
#pragma unroll
      for (int g = 0; g < 3; ++g) {
        float nx = (rn < send) ? bf2f(phy[(size_t)rn * 1536 + g * 512 + c]) : 0.f;
        o[g] = w[g][0] * pv[g] + w[g][1] * cv[g] + w[g][2] * nx + bsv[g];
        pv[g] = cv[g]; cv[g] = nx;
      }
      const unsigned sb = f2bf(o[1] * o[2]);
      if (t & 1) sp[t >> 1] |= sb << 16; else sp[t >> 1] = sb;
      X0[(size_t)(row0 + t) * 512 + c] = f2bf(o[0]);
    }
    *(uint4*)(S + (size_t)c * MTOT + row0) = make_uint4(sp[0], sp[1], sp[2], sp[3]);
    *(uint4*)(S + (size_t)c * MTOT + row0 + 8) = make_uint4(sp[4], sp[5], sp[6], sp[7]);
  }
}

__device__ __forceinline__ void rwscan_item(float* lds, CP P, int item) {
  const int tid = threadIdx.x;
  const int half = item & 1, dir = (item >> 1) & 1, h = (item >> 2) & 7, b = item >> 5;
  const int kq = tid & 7, rl = tid >> 3;
  unsigned char* ws = P->ws;
  const u16* prw = (const u16*)(ws + L0_PRW);
  const u16* Ad = (const u16*)((unsigned char*)P->out + (dir ? DO_A1 : DO_A0));
  const u16* OMd = dir ? (const u16*)(ws + L0_OM1) : (const u16*)((unsigned char*)P->out + DO_OM0);
  const float* RN = (const float*)(ws + OFF_SMALL + S_RNORM);
  u16* Y = (u16*)(ws + (dir ? L0_Y1 : L0_Y0));
  const int SSTR = 352, BUFSZ = 16 * 352;
  float* cst = lds + 2 * BUFSZ;
  __syncthreads();
  if (tid < 64) {
    const int cj = h * 64 + tid;
    cst[tid] = P->in[I_MU][cj]; cst[64 + tid] = P->in[I_MU][512 + cj]; cst[128 + tid] = P->in[I_KK][cj]; cst[192 + tid] = P->in[I_KA][cj];
    if (tid < 32) cst[256 + tid] = P->in[I_MU][1024 + h * 64 + half * 32 + tid];
  }
  const int sst = tid >> 4, sc4 = tid & 15;
  const int j0 = h * 64 + sc4 * 4;
  const int cv0 = 1024 + h * 64 + half * 32 + sc4 * 2;
  float sx[8];
#pragma unroll
  for (int j = 0; j < 8; ++j) sx[j] = 0.f;
  for (int seq = 0; seq < 2; ++seq) {
    const int Ls = seq ? 2048 : 256;
    const int rowbase = seq ? b * 2048 : MLAT + b * 256;
    const int nchunk = Ls / 16;
    uint2 R0, R1, R2, K0, K1, K2, AA, OO; unsigned V0, V1, V2; float rn = 0.f; bool hp = false, hn = false;
    auto gl = [&](int c) {
      int i = c * 16 + sst; int t = dir ? (Ls - 1 - i) : i; size_t row = rowbase + t;
      hp = t > 0; hn = t < Ls - 1;
      const size_t rp = hp ? row - 1 : row, rx = hn ? row + 1 : row;
      const u16* p = prw + row * 1792; const u16* pp = prw + rp * 1792; const u16* px = prw + rx * 1792;
      R1 = *(const uint2*)(p + j0); K1 = *(const uint2*)(p + 512 + j0);
      R0 = *(const uint2*)(pp + j0); K0 = *(const uint2*)(pp + 512 + j0);
      R2 = *(const uint2*)(px + j0); K2 = *(const uint2*)(px + 512 + j0);
      AA = *(const uint2*)(Ad + row * 512 + j0); OO = *(const uint2*)(OMd + row * 512 + j0);
      rn = RN[row * 8 + h];
      V1 = *(const unsigned*)(p + cv0); V0 = *(const unsigned*)(pp + cv0); V2 = *(const unsigned*)(px + cv0);
    };
    auto sw = [&](int buf) {
      float* sp = lds + buf * BUFSZ + sst * SSTR;
      const float fp = hp ? 1.f : 0.f, fn = hn ? 1.f : 0.f;
      const unsigned r0[2] = {R0.x, R0.y}, r1[2] = {R1.x, R1.y}, r2[2] = {R2.x, R2.y};
      const unsigned k0[2] = {K0.x, K0.y}, k1[2] = {K1.x, K1.y}, k2[2] = {K2.x, K2.y};
      const unsigned aa[2] = {AA.x, AA.y}, oo[2] = {OO.x, OO.y};
      const float4 mur4 = *(const float4*)(cst + sc4 * 4), muk4 = *(const float4*)(cst + 64 + sc4 * 4);
      const float4 kkk4 = *(const float4*)(cst + 128 + sc4 * 4), ka4 = *(const float4*)(cst + 192 + sc4 * 4);
      const float mur[4] = {mur4.x, mur4.y, mur4.z, mur4.w}, muk[4] = {muk4.x, muk4.y, muk4.z, muk4.w};
      const float kkk[4] = {kkk4.x, kkk4.y, kkk4.z, kkk4.w}, ka[4] = {ka4.x, ka4.y, ka4.z, ka4.w};
      float okk[4], ow[4], ob[4], okd[4], orr[4];
#pragma unroll
      for (int e = 0; e < 4; ++e) {
        const int q = e >> 1, sh = (e & 1) ? 0 : 16;
        auto ex = [&](unsigned u) { return __uint_as_float((u << sh) & 0xffff0000u); };
        float rc = ex(r1[q]), kc = ex(k1[q]);
        float rs = rc + mur[e] * (0.5f * (fp * ex(r0[q]) + fn * ex(r2[q])) - rc);
        float ks = kc + muk[e] * (0.5f * (fp * ex(k0[q]) + fn * ex(k2[q])) - kc);
        float a = ex(aa[q]), om = ex(oo[q]);
        float kk = ks * kkk[e] * rn;
        okk[e] = kk; ow[e] = 1.f - om; ob[e] = a * kk; okd[e] = ks * (1.f + (a - 1.f) * ka[e]); orr[e] = rs;
      }
      *(float4*)(sp + sc4 * 4) = make_float4(okk[0], okk[1], okk[2], okk[3]);
      *(float4*)(sp + 64 + sc4 * 4) = make_float4(ow[0], ow[1], ow[2], ow[3]);
      *(float4*)(sp + 128 + sc4 * 4) = make_float4(ob[0], ob[1], ob[2], ob[3]);
      *(float4*)(sp + 192 + sc4 * 4) = make_float4(okd[0], okd[1], okd[2], okd[3]);
      *(float4*)(sp + 256 + sc4 * 4) = make_float4(orr[0], orr[1], orr[2], orr[3]);
      {
        const float2 muv2 = *(const float2*)(cst + 256 + sc4 * 2);
        float va = __uint_as_float(V1 << 16), vb = __uint_as_float(V1 & 0xffff0000u);
        float o0 = va + muv2.x * (0.5f * (fp * __uint_as_float(V0 << 16) + fn * __uint_as_float(V2 << 16)) - va);
        float o1 = vb + muv2.y * (0.5f * (fp * __uint_as_float(V0 & 0xffff0000u) + fn * __uint_as_float(V2 & 0xffff0000u)) - vb);
        *(float2*)(sp + 320 + sc4 * 2) = make_float2(o0, o1);
      }
    };
    gl(0);
    __syncthreads();
    sw(0);
    __syncthreads();
    for (int c = 0; c < nchunk; ++c) {
      const int buf = c & 1;
      if (c + 1 < nchunk) gl(c + 1);
      float ykA = 0.f, ykB = 0.f;
      float4 rp0 = make_float4(0.f, 0.f, 0.f, 0.f), rp1 = make_float4(0.f, 0.f, 0.f, 0.f);
#pragma unroll
      for (int st = 0; st < 16; ++st) {
        const float* sp = lds + buf * BUFSZ + st * SSTR + kq * 8;
        const float4 k0 = *(const float4*)(sp), k1 = *(const float4*)(sp + 4);
        const float4 w0 = *(const float4*)(sp + 64), w1 = *(const float4*)(sp + 68);
        const float4 b0 = *(const float4*)(sp + 128), b1 = *(const float4*)(sp + 132);
        const float4 d0 = *(const float4*)(sp + 192), d1 = *(const float4*)(sp + 196);
        const float4 r0 = *(const float4*)(sp + 256), r1 = *(const float4*)(sp + 260);
        const float vv = lds[buf * BUFSZ + st * SSTR + 320 + rl];
        float pa = ((sx[0] * k0.x + sx[1] * k0.y) + (sx[2] * k0.z + sx[3] * k0.w)) + ((sx[4] * k1.x + sx[5] * k1.y) + (sx[6] * k1.z + sx[7] * k1.w));
        float py = ((sx[0] * rp0.x + sx[1] * rp0.y) + (sx[2] * rp0.z + sx[3] * rp0.w)) + ((sx[4] * rp1.x + sx[5] * rp1.y) + (sx[6] * rp1.z + sx[7] * rp1.w));
        red8d(pa, py);
        if (st > 0) { const int pv = st - 1; if (pv < 8) ykA = (kq == pv) ? py : ykA; else ykB = (kq == pv - 8) ? py : ykB; }
        const float sa = -pa;
        sx[0] = sx[0] * w0.x + (sa * b0.x + vv * d0.x); sx[1] = sx[1] * w0.y + (sa * b0.y + vv * d0.y);
        sx[2] = sx[2] * w0.z + (sa * b0.z + vv * d0.z); sx[3] = sx[3] * w0.w + (sa * b0.w + vv * d0.w);
        sx[4] = sx[4] * w1.x + (sa * b1.x + vv * d1.x); sx[5] = sx[5] * w1.y + (sa * b1.y + vv * d1.y);
        sx[6] = sx[6] * w1.z + (sa * b1.z + vv * d1.z); sx[7] = sx[7] * w1.w + (sa * b1.w + vv * d1.w);
        rp0 = r0; rp1 = r1;
      }
      {
        float py = ((sx[0] * rp0.x + sx[1] * rp0.y) + (sx[2] * rp0.z + sx[3] * rp0.w)) + ((sx[4] * rp1.x + sx[5] * rp1.y) + (sx[6] * rp1.z + sx[7] * rp1.w));
        float du = 0.f;
        red8d(py, du);
        ykB = (kq == 7) ? py : ykB;
      }
      {
        int i = c * 16 + kq; int t = dir ? (Ls - 1 - i) : i;
        Y[(size_t)(rowbase + t) * 512 + h * 64 + half * 32 + rl] = f2bf(ykA);
        i += 8; t = dir ? (Ls - 1 - i) : i;
        Y[(size_t)(rowbase + t) * 512 + h * 64 + half * 32 + rl] = f2bf(ykB);
      }
      if (c + 1 < nchunk) sw(buf ^ 1);
      lds_barrier();
    }
  }
}

typedef __attribute__((ext_vector_type(4))) unsigned u32x4;
__device__ __forceinline__ void hymfma_item(unsigned char* smem, CP P, int item) {
  const int tid = threadIdx.x, lane = tid & 63, w = tid >> 6;
  const int fr = lane & 15, fq = lane >> 4;
  const bool lat = item < 512;
  const int c = lat ? item : item - 512;
  const int L = lat ? 2048 : 256, nb = L >> 5, RS = L + 8;
  unsigned char* ws = P->ws;
  const u16* ST = (const u16*)(ws + L0_S) + (size_t)c * MTOT + (lat ? 0 : MLAT);
  u16* CT = (u16*)(ws + L0_HY) + (size_t)c * MTOT + (lat ? 0 : MLAT);
  const float* FT = lat ? (const float*)(ws + OFF_FILT) + (size_t)c * 4096 : (const float*)(ws + OFF_FILTC) + (size_t)c * 512;
  u16* sS = (u16*)smem;
  u16* rk0 = (u16*)(smem + 32896);
  u16* rk1 = (u16*)(smem + 32896 + 8192);
  __syncthreads();
  for (int ch = tid; ch < L; ch += NTHR) {
    const int b = ch / (L >> 3), s8 = ch % (L >> 3);
    *(uint4*)(sS + b * RS + s8 * 8) = *(const uint4*)(ST + (size_t)b * L + s8 * 8);
  }
  for (int e = tid; e < 2 * L - 1; e += NTHR) {
    const u16 v = f2bf(FT[e]);
    const int i = 2 * L - 2 - e;
    rk0[i] = v;
    if (i >= 1) rk1[i - 1] = v;
  }
  if (tid == 0) rk1[2 * L - 2] = 0;
  __syncthreads();
  const int npairs = lat ? 8 : 1;
  const int tbase = lat ? 16 * w : (4 * (w >> 1) + (w & 1));
  f32x4 acc[8][2];
#pragma unroll
  for (int p = 0; p < 8; ++p) { acc[p][0] = (f32x4){0.f, 0.f, 0.f, 0.f}; acc[p][1] = (f32x4){0.f, 0.f, 0.f, 0.f}; }
  const int cg = fr >> 3, bb = fr & 7;
  const int t1last = tbase + 4 * ((npairs - 1) >> 1) + ((npairs - 1) & 1) + 2;
  const u16* rsel = (fr & 1) ? rk0 : rk1;
  const int ioff = (L - 1) - fr + 8 * fq - ((fr & 1) ? 0 : 1);
  for (int dl = tbase - (nb - 1); dl <= t1last; ++dl) {
    const int i0 = ioff - 32 * dl;
    const unsigned* pa0 = (const unsigned*)(rsel + i0);
    const unsigned* pa1 = (const unsigned*)(rsel + i0 - 16);
    u32x4 a0v = (u32x4){pa0[0], pa0[1], pa0[2], pa0[3]};
    u32x4 a1v = (u32x4){pa1[0], pa1[1], pa1[2], pa1[3]};
    const bf16x8 A0 = __builtin_bit_cast(bf16x8, a0v), A1 = __builtin_bit_cast(bf16x8, a1v);
#pragma unroll
    for (int p = 0; p < 8; ++p) {
      if (p < npairs) {
        const int t1a = tbase + 4 * (p >> 1) + (p & 1);
        const int s1a = t1a - dl;
        if (s1a < nb && s1a + 2 >= 0) {
          const int s1 = s1a + 2 * cg;
          const bool ok = (s1 >= 0) && (s1 < nb);
          const int s1c = ok ? s1 : 0;
          u32x4 bv = *(const u32x4*)(sS + bb * RS + 32 * s1c + fq * 8);
          if (!ok) bv = (u32x4){0u, 0u, 0u, 0u};
          const bf16x8 B = __builtin_bit_cast(bf16x8, bv);
          acc[p][0] = __builtin_amdgcn_mfma_f32_16x16x32_bf16(A0, B, acc[p][0], 0, 0, 0);
          acc[p][1] = __builtin_amdgcn_mfma_f32_16x16x32_bf16(A1, B, acc[p][1], 0, 0, 0);
        }
      }
    }
  }
  const float inv = 1.f / ((const float*)(ws + OFF_SMALL + S_HNORM))[(lat ? 0 : 512) + c];
  const float skip = P->in[I_SKIP][c];
#pragma unroll
  for (int p = 0; p < 8; ++p) {
    if (p < npairs) {
      const int t1 = tbase + 4 * (p >> 1) + (p & 1) + 2 * cg;
#pragma unroll
      for (int th = 0; th < 2; ++th) {
        const int t = 32 * t1 + th * 16 + fq * 4;
        const uint2 sv = *(const uint2*)(sS + bb * RS + t);
        float o0 = acc[p][th][0] * inv + __uint_as_float(sv.x << 16) * skip;
        float o1 = acc[p][th][1] * inv + __uint_as_float(sv.x & 0xffff0000u) * skip;
        float o2 = acc[p][th][2] * inv + __uint_as_float(sv.y << 16) * skip;
        float o3 = acc[p][th][3] * inv + __uint_as_float(sv.y & 0xffff0000u) * skip;
        *(uint2*)(CT + (size_t)bb * L + t) = make_uint2(pack2(o0, o1), pack2(o2, o3));
      }
    }
  }
}

__device__ __forceinline__ void hyfinal_item(unsigned char* smem, CP P, int item) {
  const int tid = threadIdx.x;
  const int rt = item >> 3, ct = item & 7;
  const int row0 = rt * 64, c0 = ct * 64;
  const u16* CT = (const u16*)(P->ws + L0_HY);
  u16* X0 = (u16*)(P->ws + L0_X0C);
  u16* tile = (u16*)smem;
  __syncthreads();
  {
    const int i = tid >> 2, part = tid & 3;
    const u16* src = CT + (size_t)(c0 + i) * MTOT + row0 + part * 16;
    *(uint4*)(tile + i * 72 + part * 16) = *(const uint4*)src;
    *(uint4*)(tile + i * 72 + part * 16 + 8) = *(const uint4*)(src + 8);
  }
  __syncthreads();
  {
    const int r = tid >> 2, cp = tid & 3;
    u16* xp = X0 + (size_t)(row0 + r) * 512 + c0 + cp * 16;
    uint4 x0 = *(const uint4*)xp, x1 = *(const uint4*)(xp + 8);
    unsigned xin[8] = {x0.x, x0.y, x0.z, x0.w, x1.x, x1.y, x1.z, x1.w}, xo[8];
#pragma unroll
    for (int e = 0; e < 8; ++e) {
      float ya = bf2f(tile[(cp * 16 + 2 * e) * 72 + r]), yb = bf2f(tile[(cp * 16 + 2 * e + 1) * 72 + r]);
      xo[e] = pack2(__uint_as_float(xin[e] << 16) * ya, __uint_as_float(xin[e] & 0xffff0000u) * yb);
    }
    *(uint4*)xp = make_uint4(xo[0], xo[1], xo[2], xo[3]);
    *(uint4*)(xp + 8) = make_uint4(xo[4], xo[5], xo[6], xo[7]);
  }
}

__device__ __forceinline__ void rwout_phase(CP P) {
  const int lane = threadIdx.x & 63, wid = threadIdx.x >> 6;
  unsigned char* ws = P->ws;
  const u16* prw = (const u16*)(ws + L0_PRW);
  u16* Y0 = (u16*)(ws + L0_Y0); const u16* Y1 = (const u16*)(ws + L0_Y1); const u16* G = (const u16*)(ws + L0_G);
  const u16* A0 = (const u16*)((unsigned char*)P->out + DO_A0); const u16* A1 = (const u16*)((unsigned char*)P->out + DO_A1);
  const float* mu = P->in[I_MU]; const float* lnw = P->in[I_LNW]; const float* lnb = P->in[I_LNB];
  const float* rkp = P->in[I_RK]; const float* kap = P->in[I_KA];
  for (int row2 = blockIdx.x * 2; row2 < MTOT; row2 += gridDim.x * 2) {
    u16 ry0[4], ry1[4], rg[4], ra0[4], ra1[4], rv[4][3], rr[4][3], rk[4][3];
#pragma unroll
    for (int u = 0; u < 4; ++u) {
      const int row = row2 + (u >> 1), h = wid + 4 * (u & 1), col = h * 64 + lane;
      int sstart, slen; seq_of_row(row, sstart, slen);
      const int rp = (row > sstart) ? row - 1 : row, rn = (row + 1 < sstart + slen) ? row + 1 : row;
      ry0[u] = Y0[(size_t)row * 512 + col]; ry1[u] = Y1[(size_t)row * 512 + col]; rg[u] = G[(size_t)row * 512 + col];
      ra0[u] = A0[(size_t)row * 512 + col]; ra1[u] = A1[(size_t)row * 512 + col];
      const u16* p0 = prw + (size_t)rp * 1792 + col; const u16* p1 = prw + (size_t)row * 1792 + col; const u16* p2 = prw + (size_t)rn * 1792 + col;
      rr[u][0] = p0[0]; rr[u][1] = p1[0]; rr[u][2] = p2[0];
      rk[u][0] = p0[512]; rk[u][1] = p1[512]; rk[u][2] = p2[512];
      rv[u][0] = p0[1024]; rv[u][1] = p1[1024]; rv[u][2] = p2[1024];
    }
#pragma unroll
    for (int u = 0; u < 4; ++u) {
      const int row = row2 + (u >> 1), h = wid + 4 * (u & 1), col = h * 64 + lane;
      int sstart, slen; seq_of_row(row, sstart, slen);
      const bool hp = row > sstart, hn = row + 1 < sstart + slen;
      float y = bf2f(ry0[u]) + bf2f(ry1[u]);
      float mean = wave_sum(y) * (1.f / 64.f);
      float dv = y - mean;
      float var = wave_sum(dv * dv) * (1.f / 64.f);
      float yn = dv * rsqrtf(var + 64e-5f);
      float vc = bf2f(rv[u][1]), rc = bf2f(rr[u][1]), kc = bf2f(rk[u][1]);
      float vs = vc + mu[1024 + col] * (0.5f * ((hp ? bf2f(rv[u][0]) : 0.f) + (hn ? bf2f(rv[u][2]) : 0.f)) - vc);
      float rs = rc + mu[col] * (0.5f * ((hp ? bf2f(rr[u][0]) : 0.f) + (hn ? bf2f(rr[u][2]) : 0.f)) - rc);
      float ks = kc + mu[512 + col] * (0.5f * ((hp ? bf2f(rk[u][0]) : 0.f) + (hn ? bf2f(rk[u][2]) : 0.f)) - kc);
      float bq = rs * ks * rkp[col] * (2.f + (bf2f(ra0[u]) + bf2f(ra1[u]) - 2.f) * kap[col]);
      float bonus = wave_sum(bq);
      float o = (yn * lnw[col] + lnb[col] + bonus * vs) * bf2f(rg[u]);
      Y0[(size_t)row * 512 + col] = f2bf(o);
    }
  }
}

__device__ __forceinline__ void gdnprep_phase(unsigned char* smem, CP P) {
  const int tid = threadIdx.x;
  unsigned char* ws = P->ws;
  u16* pq = (u16*)(ws + L1_PQKV);
  const u16* halo = (const u16*)(ws + OFF_XCTX);
  const float* cw = P->in[I_DNCW];
  u16* raw = (u16*)smem;
  float* wl = (float*)(smem + 130 * 272);
  const int r = tid >> 1, hf = tid & 1;
  for (int it = blockIdx.x; it < 144 * 24; it += gridDim.x) {
    const int tile = it / 24, cb = it % 24, which = cb >> 3;
    const int row0 = tile * 128;
    int sstart, slen; seq_of_row(row0, sstart, slen);
    const bool hp = row0 > sstart, hn = row0 + 128 < sstart + slen;
    __syncthreads();
#pragma unroll
    for (int i = 0; i < 8; ++i) {
      int c = tid + i * 256, rr = c >> 4, kc = c & 15;
      *(uint4*)(raw + (rr + 1) * 136 + kc * 8) = *(const uint4*)(pq + (size_t)(row0 + rr) * 3072 + cb * 128 + kc * 8);
    }
    if (tid < 16) {
      uint4 v = make_uint4(0, 0, 0, 0);
      if (hp) v = *(const uint4*)(halo + (size_t)((tile - 1) * 2 + 1) * 3072 + cb * 128 + tid * 8);
      *(uint4*)(raw + tid * 8) = v;
    } else if (tid < 32) {
      uint4 v = make_uint4(0, 0, 0, 0);
      if (hn) v = *(const uint4*)(halo + (size_t)((tile + 1) * 2) * 3072 + cb * 128 + (tid - 16) * 8);
      *(uint4*)(raw + 129 * 136 + (tid - 16) * 8) = v;
    }
    for (int e = tid; e < 384; e += NTHR) wl[e] = cw[(e >> 7) * 3072 + cb * 128 + (e & 127)];
    __syncthreads();
    float o[64]; float ss = 0.f;
#pragma unroll
    for (int j = 0; j < 8; ++j) {
      const uint4 a4 = *(const uint4*)(raw + r * 136 + hf * 64 + j * 8);
      const uint4 c4 = *(const uint4*)(raw + (r + 1) * 136 + hf * 64 + j * 8);
      const uint4 n4 = *(const uint4*)(raw + (r + 2) * 136 + hf * 64 + j * 8);
      const unsigned a[4] = {a4.x, a4.y, a4.z, a4.w}, c[4] = {c4.x, c4.y, c4.z, c4.w}, n[4] = {n4.x, n4.y, n4.z, n4.w};
#pragma unroll
      for (int e = 0; e < 8; ++e) {
        const int q = e >> 1, sh = (e & 1) ? 0 : 16;
        auto ex = [&](unsigned u) { return __uint_as_float((u << sh) & 0xffff0000u); };
        const int col = hf * 64 + j * 8 + e;
        float v = siluf_(wl[col] * ex(a[q]) + wl[128 + col] * ex(c[q]) + wl[256 + col] * ex(n[q]));
        o[j * 8 + e] = v; ss += v * v;
      }
    }
    ss += __int_as_float(__builtin_amdgcn_mov_dpp(__float_as_int(ss), 0xB1, 0xF, 0xF, true));
    const float sc = (which == 0) ? rsqrtf(ss + 1e-6f) * 0.08838834764831845f : ((which == 1) ? rsqrtf(ss + 1e-6f) : 1.f);
    u16* dst = pq + (size_t)(row0 + r) * 3072 + cb * 128 + hf * 64;
#pragma unroll
    for (int j = 0; j < 8; ++j)
      *(uint4*)(dst + j * 8) = make_uint4(pack2(o[j * 8] * sc, o[j * 8 + 1] * sc), pack2(o[j * 8 + 2] * sc, o[j * 8 + 3] * sc),
                                          pack2(o[j * 8 + 4] * sc, o[j * 8 + 5] * sc), pack2(o[j * 8 + 6] * sc, o[j * 8 + 7] * sc));
  }
  __syncthreads();
  {
    const float* pab = (const float*)(ws + OFF_SMALL + S_PAB);
    float* EG = (float*)(ws + OFF_SMALL + S_EG); float* BE = (float*)(ws + OFF_SMALL + S_BETA);
    const float* alog = P->in[I_DNALOG]; const float* dtb = P->in[I_DNDT];
    for (int e = blockIdx.x * NTHR + tid; e < MTOT * 16; e += gridDim.x * NTHR) {
      const int row = e >> 4, j = e & 15;
      float av = pab[(size_t)row * 32 + j], bv = pab[(size_t)row * 32 + 16 + j];
      float g = -__expf(alog[j]) * softplusf_(av + dtb[j]);
      EG[e] = g;
      BE[e] = sigmoidf_(bv);
    }
  }
}

__device__ __forceinline__ void gdnscan_item(float* lds, CP P, int item) {
  const int tid = threadIdx.x;
  const int cgq = item & 3, dir = (item >> 2) & 1, h = (item >> 3) & 7, b = item >> 6;
  const int kq = tid & 15, cl = tid >> 4;
  unsigned char* ws = P->ws;
  const u16* pq = (const u16*)(ws + L1_PQKV);
  const float* EG = (const float*)(ws + OFF_SMALL + S_EG); const float* BE = (const float*)(ws + OFF_SMALL + S_BETA);
  u16* O = (u16*)(ws + (dir ? L1_O1 : L1_O0));
  const int SSTR = 292, BUFSZ = 16 * 292;
  __syncthreads();
  v2f s[8];
#pragma unroll
  for (int j = 0; j < 8; ++j) s[j] = (v2f){0.f, 0.f};
  const int qst = tid >> 4, qc8 = tid & 15;
  const int vst = (tid & 63) >> 2, vc8 = tid & 3;
  const int wv = tid >> 6;
  for (int seq = 0; seq < 2; ++seq) {
    const int Ls = seq ? 2048 : 256;
    const int rowbase = seq ? b * 2048 : MLAT + b * 256;
    const int nchunk = Ls / 16;
    uint4 Q1, K1, V1; float sc0 = 0.f, sc1 = 0.f;
    auto gl = [&](int c) {
      {
        int i = c * 16 + qst; int t = dir ? (Ls - 1 - i) : i; size_t row = rowbase + t;
        const u16* p = pq + row * 3072 + h * 128 + qc8 * 8;
        Q1 = *(const uint4*)p; K1 = *(const uint4*)(p + 1024);
      }
      if (wv == 0) {
        int i = c * 16 + vst; int t = dir ? (Ls - 1 - i) : i; size_t row = rowbase + t;
        V1 = *(const uint4*)(pq + row * 3072 + 2048 + h * 128 + cgq * 32 + vc8 * 8);
      } else if (wv == 1 && (tid & 63) < 16) {
        int i = c * 16 + (tid & 63); int t = dir ? (Ls - 1 - i) : i; size_t row = rowbase + t;
        sc0 = EG[row * 16 + dir * 8 + h]; sc1 = BE[row * 16 + dir * 8 + h];
      }
    };
    auto sw = [&](int buf) {
      float* bp = lds + buf * BUFSZ;
      {
        float* sp = bp + qst * SSTR + qc8 * 4;
        *(float4*)(sp) = make_float4(__uint_as_float(Q1.x << 16), __uint_as_float(Q1.x & 0xffff0000u), __uint_as_float(Q1.y << 16), __uint_as_float(Q1.y & 0xffff0000u));
        *(float4*)(sp + 64) = make_float4(__uint_as_float(Q1.z << 16), __uint_as_float(Q1.z & 0xffff0000u), __uint_as_float(Q1.w << 16), __uint_as_float(Q1.w & 0xffff0000u));
        *(float4*)(sp + 128) = make_float4(__uint_as_float(K1.x << 16), __uint_as_float(K1.x & 0xffff0000u), __uint_as_float(K1.y << 16), __uint_as_float(K1.y & 0xffff0000u));
        *(float4*)(sp + 192) = make_float4(__uint_as_float(K1.z << 16), __uint_as_float(K1.z & 0xffff0000u), __uint_as_float(K1.w << 16), __uint_as_float(K1.w & 0xffff0000u));
      }
      if (wv == 0) {
        float* sp = bp + vst * SSTR + 256 + vc8 * 8;
        *(float4*)(sp) = make_float4(__uint_as_float(V1.x << 16), __uint_as_float(V1.x & 0xffff0000u), __uint_as_float(V1.y << 16), __uint_as_float(V1.y & 0xffff0000u));
        *(float4*)(sp + 4) = make_float4(__uint_as_float(V1.z << 16), __uint_as_float(V1.z & 0xffff0000u), __uint_as_float(V1.w << 16), __uint_as_float(V1.w & 0xffff0000u));
      } else if (wv == 1 && (tid & 63) < 16) {
        bp[(tid & 63) * SSTR + 288] = sc0; bp[(tid & 63) * SSTR + 289] = sc1;
      }
    };
    gl(0);
    __syncthreads();
    sw(0);
    __syncthreads();
    for (int c = 0; c < nchunk; ++c) {
      const int buf = c & 1;
      if (c + 1 < nchunk) gl(c + 1);
      v2f okeep = (v2f){0.f, 0.f};
      float4 qpa = make_float4(0.f, 0.f, 0.f, 0.f), qpb = make_float4(0.f, 0.f, 0.f, 0.f);
      float4 qan, qbn, kan, kbn; v2f vvn; float egn, betan;
      {
        const float* sp = lds + buf * BUFSZ;
        qan = *(const float4*)(sp + kq * 4); qbn = *(const float4*)(sp + 64 + kq * 4);
        kan = *(const float4*)(sp + 128 + kq * 4); kbn = *(const float4*)(sp + 192 + kq * 4);
        vvn = *(const v2f*)(sp + 256 + cl * 2); egn = sp[288]; betan = sp[289];
      }
#pragma unroll
      for (int st = 0; st < 16; ++st) {
        const float4 qa = qan, qb = qbn, ka = kan, kb = kbn; const v2f vv = vvn; const float eg = egn, beta = betan;
        if (st < 15) {
          const float* sp = lds + buf * BUFSZ + (st + 1) * SSTR;
          qan = *(const float4*)(sp + kq * 4); qbn = *(const float4*)(sp + 64 + kq * 4);
          kan = *(const float4*)(sp + 128 + kq * 4); kbn = *(const float4*)(sp + 192 + kq * 4);
          vvn = *(const v2f*)(sp + 256 + cl * 2); egn = sp[288]; betan = sp[289];
        }
        __builtin_amdgcn_sched_barrier(0);
        v2f pk = (s[0] * ka.x + s[1] * ka.y + s[2] * ka.z + s[3] * ka.w) + (s[4] * kb.x + s[5] * kb.y + s[6] * kb.z + s[7] * kb.w);
        v2f po = (s[0] * qpa.x + s[1] * qpa.y + s[2] * qpa.z + s[3] * qpa.w) + (s[4] * qpb.x + s[5] * qpb.y + s[6] * qpb.z + s[7] * qpb.w);
        red16x2(pk, po);
        if (st > 0) { okeep.x = (kq == st - 1) ? po.x : okeep.x; okeep.y = (kq == st - 1) ? po.y : okeep.y; }
        const v2f cc = (vv - pk * eg) * beta;
        s[0] = s[0] * eg + cc * ka.x; s[1] = s[1] * eg + cc * ka.y; s[2] = s[2] * eg + cc * ka.z; s[3] = s[3] * eg + cc * ka.w;
        s[4] = s[4] * eg + cc * kb.x; s[5] = s[5] * eg + cc * kb.y; s[6] = s[6] * eg + cc * kb.z; s[7] = s[7] * eg + cc * kb.w;
        qpa = qa; qpb = qb;
        __builtin_amdgcn_sched_barrier(0);
      }
      {
        v2f po = (s[0] * qpa.x + s[1] * qpa.y + s[2] * qpa.z + s[3] * qpa.w) + (s[4] * qpb.x + s[5] * qpb.y + s[6] * qpb.z + s[7] * qpb.w);
        v2f dummy = po;
        red16x2(po, dummy);
        okeep.x = (kq == 15) ? po.x : okeep.x; okeep.y = (kq == 15) ? po.y : okeep.y;
      }
      if (seq) {
        int i = c * 16 + kq; int t = dir ? (Ls - 1 - i) : i;
        *(unsigned*)(O + (size_t)(rowbase + t) * 1024 + h * 128 + cgq * 32 + cl * 2) = pack2(okeep.x, okeep.y);
      }
      if (c + 1 < nchunk) sw(buf ^ 1);
      __syncthreads();
    }
  }
}

#define A_RL(i_, j_) __int_as_float(__builtin_amdgcn_readlane(__float_as_int(areg[((i_) * 16 + (j_)) >> 6]), ((i_) * 16 + (j_)) & 63))
__device__ __forceinline__ void gdnchunk_item(unsigned char* smem, CP P, int item) {
  const int tid = threadIdx.x, lane = tid & 63, w = tid >> 6, fr = lane & 15, fq = lane >> 4;
  const int cgq = item & 1, dir = (item >> 1) & 1, h = (item >> 2) & 7, b = item >> 5;
  unsigned char* ws = P->ws;
  const u16* pq = (const u16*)(ws + L1_PQKV);
  const float* GG = (const float*)(ws + OFF_SMALL + S_EG); const float* BE = (const float*)(ws + OFF_SMALL + S_BETA);
  u16* O = (u16*)(ws + (dir ? L1_O1 : L1_O0));
  u16* Kb = (u16*)(smem + 0);
  u16* Qb = (u16*)(smem + 4352);
  u16* Wb = (u16*)(smem + 8704);
  u16* SbT = (u16*)(smem + 13056);
  u16* KgT = (u16*)(smem + 30464);
  u16* VNT = (u16*)(smem + 40704);
  u16* RT = (u16*)(smem + 45824);
  u16* Pb = (u16*)(smem + 50944);
  u16* Tb = (u16*)(smem + 52224);
  float* Am = (float*)(smem + 53504);
  float* gsc = (float*)(smem + 54528);
  float* Vf = (float*)(smem + 54848);
  __syncthreads();
  for (int e = tid; e < 58944 / 4; e += NTHR) ((unsigned*)smem)[e] = 0u;
  f32x4 accS[4][2];
#pragma unroll
  for (int a = 0; a < 4; ++a)
#pragma unroll
    for (int c = 0; c < 2; ++c) accS[a][c] = (f32x4){0.f, 0.f, 0.f, 0.f};
  const int si = tid >> 4, sc8 = tid & 15;
  const int vi = (tid & 127) >> 3, vc8 = tid & 7;
  __syncthreads();
  for (int seq = 0; seq < 2; ++seq) {
    const int Ls = seq ? 2048 : 256;
    const int rowbase = seq ? b * 2048 : MLAT + b * 256;
    const int nchunk = Ls / 16;
    uint4 Q1, K1, V1 = make_uint4(0, 0, 0, 0); float sg = 0.f, sb = 0.f;
    auto gl = [&](int c) {
      {
        int i = c * 16 + si; int t = dir ? (Ls - 1 - i) : i; size_t row = rowbase + t;
        const u16* p = pq + row * 3072 + h * 128 + sc8 * 8;
        Q1 = *(const uint4*)p; K1 = *(const uint4*)(p + 1024);
      }
      if (w < 2) {
        int i = c * 16 + vi; int t = dir ? (Ls - 1 - i) : i; size_t row = rowbase + t;
        V1 = *(const uint4*)(pq + row * 3072 + 2048 + h * 128 + cgq * 64 + vc8 * 8);
      }
      {
        int i = c * 16 + (lane & 15); int t = dir ? (Ls - 1 - i) : i; size_t row = rowbase + t;
        sg = GG[row * 16 + dir * 8 + h]; sb = BE[row * 16 + dir * 8 + h];
      }
    };
    gl(0);
    for (int c = 0; c < nchunk; ++c) {
      *(uint4*)(Qb + si * 136 + sc8 * 8) = Q1;
      *(uint4*)(Kb + si * 136 + sc8 * 8) = K1;
      {
        float v = sg;
        v += __int_as_float(__builtin_amdgcn_update_dpp(0, __float_as_int(v), 0x111, 0xf, 0xf, false));
        v += __int_as_float(__builtin_amdgcn_update_dpp(0, __float_as_int(v), 0x112, 0xf, 0xf, false));
        v += __int_as_float(__builtin_amdgcn_update_dpp(0, __float_as_int(v), 0x114, 0xf, 0xf, false));
        v += __int_as_float(__builtin_amdgcn_update_dpp(0, __float_as_int(v), 0x118, 0xf, 0xf, false));
        const float tot = __int_as_float(__builtin_amdgcn_readlane(__float_as_int(v), 15));
        if (w == 1 && lane < 16) { gsc[lane] = sg; gsc[16 + lane] = sb; gsc[32 + lane] = v; gsc[48 + lane] = __expf(v); gsc[64 + lane] = __expf(tot - v); }
        const float gcs = __shfl(v, (lane & 48) | (si & 15)), bts = __shfl(sb, (lane & 48) | (si & 15));
        const float el = __expf(tot - gcs), bw = bts * __expf(gcs);
        const unsigned kk4[4] = {K1.x, K1.y, K1.z, K1.w};
        unsigned kw[4];
#pragma unroll
        for (int e = 0; e < 8; e += 2) {
          const float k0 = __uint_as_float(kk4[e >> 1] << 16), k1 = __uint_as_float(kk4[e >> 1] & 0xffff0000u);
          KgT[(sc8 * 8 + e) * 40 + si] = f2bf(k0 * el);
          KgT[(sc8 * 8 + e + 1) * 40 + si] = f2bf(k1 * el);
          kw[e >> 1] = pack2(k0 * bw, k1 * bw);
        }
        *(uint4*)(Wb + si * 136 + sc8 * 8) = make_uint4(kw[0], kw[1], kw[2], kw[3]);
        const float bt = __shfl(sb, (lane & 48) | vi);
        if (w < 2) {
          float* vp = Vf + vi * 64 + vc8 * 8;
          *(float4*)vp = make_float4(bt * __uint_as_float(V1.x << 16), bt * __uint_as_float(V1.x & 0xffff0000u), bt * __uint_as_float(V1.y << 16), bt * __uint_as_float(V1.y & 0xffff0000u));
          *(float4*)(vp + 4) = make_float4(bt * __uint_as_float(V1.z << 16), bt * __uint_as_float(V1.z & 0xffff0000u), bt * __uint_as_float(V1.w << 16), bt * __uint_as_float(V1.w & 0xffff0000u));
        }
      }
      __syncthreads();
      if (c + 1 < nchunk) gl(c + 1);
      f32x4 acco = (f32x4){0.f, 0.f, 0.f, 0.f};
      if (w < 2) {
        f32x4 a4 = (f32x4){0.f, 0.f, 0.f, 0.f};
        const u16* ab = (w == 0) ? Kb : Qb;
#pragma unroll
        for (int ks = 0; ks < 4; ++ks) {
          const bf16x8 fa = *(const bf16x8*)(ab + fr * 136 + ks * 32 + fq * 8);
          const bf16x8 fb = *(const bf16x8*)(Kb + fr * 136 + ks * 32 + fq * 8);
          a4 = __builtin_amdgcn_mfma_f32_16x16x32_bf16(fa, fb, a4, 0, 0, 0);
        }
        const float gj = gsc[32 + fr];
#pragma unroll
        for (int jj = 0; jj < 4; ++jj) {
          const int i = fq * 4 + jj;
          const float dec = __expf(fminf(gsc[32 + i] - gj, 0.f));
          if (w == 0) Am[i * 16 + fr] = (fr < i) ? gsc[16 + i] * a4[jj] * dec : 0.f;
          else Pb[i * 40 + fr] = f2bf((fr <= i) ? a4[jj] * dec : 0.f);
        }
      }
      {
        const int nt = w;
        f32x4 ks4 = (f32x4){0.f, 0.f, 0.f, 0.f};
#pragma unroll
        for (int ks = 0; ks < 4; ++ks) {
          const bf16x8 fb = *(const bf16x8*)(SbT + (nt * 16 + fr) * 136 + ks * 32 + fq * 8);
          const bf16x8 fa = *(const bf16x8*)(Qb + fr * 136 + ks * 32 + fq * 8);
          const bf16x8 fw = *(const bf16x8*)(Wb + fr * 136 + ks * 32 + fq * 8);
          acco = __builtin_amdgcn_mfma_f32_16x16x32_bf16(fa, fb, acco, 0, 0, 0);
          ks4 = __builtin_amdgcn_mfma_f32_16x16x32_bf16(fw, fb, ks4, 0, 0, 0);
        }
        float rr[4];
#pragma unroll
        for (int jj = 0; jj < 4; ++jj) rr[jj] = Vf[(fq * 4 + jj) * 64 + nt * 16 + fr] - ks4[jj];
        *(uint2*)(RT + (nt * 16 + fr) * 40 + fq * 4) = make_uint2(pack2(rr[0], rr[1]), pack2(rr[2], rr[3]));
      }
      __syncthreads();
      if (w == 0) {
        float areg[4];
#pragma unroll
        for (int q = 0; q < 4; ++q) areg[q] = Am[q * 64 + lane];
        float x[16];
#pragma unroll
        for (int i = 0; i < 16; ++i) x[i] = (i == fr) ? 1.f : 0.f;
#pragma unroll
        for (int j2 = 0; j2 < 15; ++j2)
#pragma unroll
          for (int i = j2 + 1; i < 16; ++i) x[i] -= A_RL(i, j2) * x[j2];
        if (lane < 16) {
#pragma unroll
          for (int i = 0; i < 16; ++i) Tb[i * 40 + lane] = f2bf(x[i]);
        }
      }
      __syncthreads();
      {
        const int nt = w;
        const bf16x8 ft = *(const bf16x8*)(Tb + fr * 40 + fq * 8);
        const bf16x8 fb = *(const bf16x8*)(RT + (nt * 16 + fr) * 40 + fq * 8);
        const f32x4 vn = __builtin_amdgcn_mfma_f32_16x16x32_bf16(ft, fb, (f32x4){0.f, 0.f, 0.f, 0.f}, 0, 0, 0);
        *(uint2*)(VNT + (nt * 16 + fr) * 40 + fq * 4) = make_uint2(pack2(vn[0], vn[1]), pack2(vn[2], vn[3]));
      }
      __syncthreads();
      {
        const int nt = w;
        const bf16x8 fa = *(const bf16x8*)(Pb + fr * 40 + fq * 8);
        f32x4 ao = acco;
#pragma unroll
        for (int jj = 0; jj < 4; ++jj) ao[jj] *= gsc[48 + fq * 4 + jj];
        const bf16x8 fb = *(const bf16x8*)(VNT + (nt * 16 + fr) * 40 + fq * 8);
        ao = __builtin_amdgcn_mfma_f32_16x16x32_bf16(fa, fb, ao, 0, 0, 0);
        if (seq) {
#pragma unroll
          for (int jj = 0; jj < 4; ++jj) {
            const int i = c * 16 + fq * 4 + jj; const int t = dir ? (Ls - 1 - i) : i;
            O[(size_t)(rowbase + t) * 1024 + h * 128 + cgq * 64 + nt * 16 + fr] = f2bf(ao[jj]);
          }
        }
      }
      {
        const float egl = gsc[48 + 15];
        const bf16x8 fb0 = *(const bf16x8*)(KgT + ((2 * w) * 16 + fr) * 40 + fq * 8);
        const bf16x8 fb1 = *(const bf16x8*)(KgT + ((2 * w + 1) * 16 + fr) * 40 + fq * 8);
#pragma unroll
        for (int vt = 0; vt < 4; ++vt) {
          const bf16x8 fa = *(const bf16x8*)(VNT + (vt * 16 + fr) * 40 + fq * 8);
          f32x4 a0 = accS[vt][0], a1 = accS[vt][1];
#pragma unroll
          for (int jj = 0; jj < 4; ++jj) { a0[jj] *= egl; a1[jj] *= egl; }
          a0 = __builtin_amdgcn_mfma_f32_16x16x32_bf16(fa, fb0, a0, 0, 0, 0);
          a1 = __builtin_amdgcn_mfma_f32_16x16x32_bf16(fa, fb1, a1, 0, 0, 0);
          accS[vt][0] = a0; accS[vt][1] = a1;
#pragma unroll
          for (int jj = 0; jj < 4; ++jj) {
            SbT[(vt * 16 + fq * 4 + jj) * 136 + (2 * w) * 16 + fr] = f2bf(a0[jj]);
            SbT[(vt * 16 + fq * 4 + jj) * 136 + (2 * w + 1) * 16 + fr] = f2bf(a1[jj]);
          }
        }
      }
      __syncthreads();
    }
  }
}

__device__ __forceinline__ void gdngate_phase(CP P) {
  const int lane = threadIdx.x & 63, wid = threadIdx.x >> 6;
  unsigned char* ws = P->ws;
  u16* O0 = (u16*)(ws + L1_O0); const u16* O1 = (const u16*)(ws + L1_O1); const u16* PZ = (const u16*)(ws + L1_PZ);
  const float nw0 = P->in[I_DNNORM][lane * 2], nw1 = P->in[I_DNNORM][lane * 2 + 1];
  for (int row2 = blockIdx.x * 2; row2 < MLAT; row2 += gridDim.x * 2) {
    unsigned ra[4], rb[4], rz[4];
#pragma unroll
    for (int u = 0; u < 4; ++u) {
      const size_t idx = (size_t)(row2 + (u >> 1)) * 1024 + (wid + 4 * (u & 1)) * 128 + lane * 2;
      ra[u] = *(const unsigned*)(O0 + idx); rb[u] = *(const unsigned*)(O1 + idx); rz[u] = *(const unsigned*)(PZ + idx);
    }
#pragma unroll
    for (int u = 0; u < 4; ++u) {
      const size_t idx = (size_t)(row2 + (u >> 1)) * 1024 + (wid + 4 * (u & 1)) * 128 + lane * 2;
      float o1 = __uint_as_float(ra[u] << 16) + __uint_as_float(rb[u] << 16);
      float o2 = __uint_as_float(ra[u] & 0xffff0000u) + __uint_as_float(rb[u] & 0xffff0000u);
      float ss = wave_sum(o1 * o1 + o2 * o2);
      float rs = rsqrtf(ss * (1.f / 128.f) + 1e-6f);
      float z1 = __uint_as_float(rz[u] << 16), z2 = __uint_as_float(rz[u] & 0xffff0000u);
      *(unsigned*)(O0 + idx) = pack2(o1 * rs * nw0 * siluf_(z1), o2 * rs * nw1 * siluf_(z2));
    }
  }
}

__device__ __forceinline__ void final_norm_phase(CP P) {
  const int lane = threadIdx.x & 63, wid = threadIdx.x >> 6;
  const float* nw = P->in[I_FNORM];
  for (int row = blockIdx.x * 4 + wid; row < MLAT; row += gridDim.x * 4) {
    float* src = P->out + (size_t)row * 1024;
    float4 v[4]; float ss = 0.f;
#pragma unroll
    for (int i = 0; i < 4; ++i) { v[i] = *(const float4*)(src + (i * 64 + lane) * 4); ss += v[i].x * v[i].x + v[i].y * v[i].y + v[i].z * v[i].z + v[i].w * v[i].w; }
    ss = wave_sum(ss);
    const float rs = rsqrtf(ss * (1.f / 1024.f) + 1e-6f);
#pragma unroll
    for (int i = 0; i < 4; ++i) {
      int c = (i * 64 + lane) * 4;
      float4 w = *(const float4*)(nw + c);
      *(float4*)(src + c) = make_float4(v[i].x * rs * w.x, v[i].y * rs * w.y, v[i].z * rs * w.z, v[i].w * rs * w.w);
    }
  }
}

#ifndef PMASK
#define PMASK 0xFFFFFFFFu
#endif
#define PM(k) if (PMASK & (1u << (k))) if (CP P = launder(P0))
__global__ void __launch_bounds__(NTHR, 2) fwd_megakernel(Params Parg) {
  extern __shared__ __attribute__((aligned(16))) unsigned char smem[];
  cg::grid_group grid = cg::this_grid();
  float* ldsf = (float*)smem;
  CP P0 = (CP)__builtin_amdgcn_kernarg_segment_ptr();
  unsigned char* ws = P0->ws;
  const int G = gridDim.x, bx = blockIdx.x;
  float* modv = (float*)(ws + OFF_SMALL + S_MODV);
  float* xctx = (float*)(ws + OFF_XCTX);
  volatile LAS unsigned* xst = (volatile LAS unsigned*)((LAS unsigned char*)smem + (LDS_BYTES - 32));
  if (threadIdx.x < 2) xst[threadIdx.x] = 0u;
  __syncthreads();
  XcdBarrier xbar = xcd_barrier_post((unsigned*)(ws + OFF_SMALL + S_BAR), xst);

  PM(0) {
    if (bx == 0) { float* hn = (float*)(ws + OFF_SMALL + S_HNORM); for (int e = threadIdx.x; e < 1024; e += NTHR) hn[e] = 0.f;
      if (threadIdx.x == 0) *(int*)(ws + OFF_SMALL + S_PAB) = 0; }
    for (int it = bx; it < 384; it += G) modv_item(ldsf, P, it);
    for (int it = bx; it < 576; it += G) h3_item(ldsf, P, it);
    wconv_layer(ldsf, P, 0, G - 1 - bx, G);
  }
  if (gridDim.x == 0x7fffffffu) grid.sync();
  xcd_barrier(xbar);
  PM(1) {
    for (int it = bx; it < 288; it += G) kun_item(ldsf, P, it);
    norm_phase(P->in[I_X], P->in[I_CTX], MTOT, P->in[I_NMIX], modv, 0, 1, (u16*)(ws + L0_H));
  }
  xcd_barrier(xbar);
  PM(2) {
    ASrc a{(const u16*)(ws + L0_H), 1024, (const u16*)(ws + L0_H), 1024, 1 << 30};
    gemm_phase(smem, a, (const u16*)(ws + W_IN), MTOT, 3328, 1024, EpiInProj0{(u16*)(ws + L0_PRW), (u16*)(ws + L0_PHY)});
  }
  xcd_barrier(xbar);
  PM(3) {
    for (int it = bx; it < 1152 * 2; it += G) { if (it < 1152) lrprep_item(P, it); else hyprep_item(P, it - 1152); }
  }
  xcd_barrier(xbar);
  PM(3) {
    u16* A0p = (u16*)((unsigned char*)P->out + DO_A0); u16* A1p = (u16*)((unsigned char*)P->out + DO_A1);
    u16* OM0p = (u16*)((unsigned char*)P->out + DO_OM0); u16* OM1p = (u16*)(ws + L0_OM1);
    const u16* LRp = (const u16*)(ws + L0_LR);
    { ASrc a{LRp, 256, LRp, 256, 1 << 30};
      gemm_phase(smem, a, (const u16*)(ws + W_LRW), MTOT, 1024, 64, EpiLrW{OM0p, OM1p, P->in[I_RW0]}); }
    { ASrc a{LRp + 64, 256, LRp + 64, 256, 1 << 30};
      gemm_phase(smem, a, (const u16*)(ws + W_LRA), MTOT, 1024, 64, EpiLrA{A0p, A1p, P->in[I_A0]}); }
    { ASrc a{LRp + 128, 256, LRp + 128, 256, 1 << 30};
      gemm_phase(smem, a, (const u16*)(ws + W_LRG), MTOT, 512, 128, EpiLrG{(u16*)(ws + L0_G)}); }
  }
  xcd_barrier(xbar);
  PM(4) {
    if (bx < (G >> 1)) for (int it = bx; it < 256; it += (G >> 1)) rwscan_item(ldsf, P, it);
    int* qctr = (int*)(ws + OFF_SMALL + S_PAB);
    int* qsh = (int*)(smem + LDS_BYTES - 16);
    for (;;) {
      __syncthreads();
      if (threadIdx.x == 0) *qsh = atomicAdd(qctr, 1);
      __syncthreads();
      const int it = *qsh;
      if (it >= 1024) break;
      hymfma_item(smem, P, it);
    }
  }
  xcd_barrier(xbar);
  PM(5) { rwout_phase(P); for (int it = bx; it < 288 * 8; it += G) hyfinal_item(smem, P, it); }
  xcd_barrier(xbar);
  PM(6) {
    ASrc a{(const u16*)(ws + L0_Y0), 512, (const u16*)(ws + L0_X0C), 512, 512};
    gemm_phase(smem, a, (const u16*)(ws + W_OUT), MTOT, 1024, 1024, EpiResid{P->in[I_X], P->in[I_CTX], P->out, xctx, modv + 2 * 1024});
  }
  xcd_barrier(xbar);
  PM(7) norm_phase(P->out, xctx, MTOT, P->in[I_NMLP], modv, 3, 4, (u16*)(ws + L0_H));
  xcd_barrier(xbar);
  PM(8) {
    ASrc a{(const u16*)(ws + L0_H), 1024, (const u16*)(ws + L0_H), 1024, 1 << 30};
    gemm_phase(smem, a, (const u16*)(ws + W_1), MTOT, 4096, 1024, EpiRelu2{(u16*)(ws + L0_U)});
  }
  xcd_barrier(xbar);
  PM(9) {
    ASrc a{(const u16*)(ws + L0_U), 4096, (const u16*)(ws + L0_U), 4096, 1 << 30};
    gemm_phase(smem, a, (const u16*)(ws + W_2), MTOT, 1024, 4096, EpiResid{P->out, xctx, P->out, xctx, modv + 5 * 1024});
  }
  xcd_barrier(xbar);
  const float* modv1 = modv + 9 * 6144;
  PM(10) {
    norm_phase(P->out, xctx, MTOT, P->in[I_NMIX] + 1024, modv1, 0, 1, (u16*)(ws + L1_H));
    wconv_layer(ldsf, P, 1, bx, G);
  }
  xcd_barrier(xbar);
  PM(11) {
    ASrc a{(const u16*)(ws + L1_H), 1024, (const u16*)(ws + L1_H), 1024, 1 << 30};
    gemm_phase(smem, a, (const u16*)(ws + W_IN), MTOT, 4224, 1024,
               EpiInProj1{(u16*)(ws + L1_PQKV), (u16*)(ws + L1_PZ), (float*)(ws + OFF_SMALL + S_PAB), (u16*)(ws + OFF_XCTX)});
  }
  xcd_barrier(xbar);
  PM(12) gdnprep_phase(smem, P);
  xcd_barrier(xbar);
  PM(13) { if (bx < (G >> 1)) for (int it = bx; it < 256; it += (G >> 1)) gdnchunk_item(smem, P, it); }
  xcd_barrier(xbar);
  PM(14) gdngate_phase(P);
  xcd_barrier(xbar);
  PM(15) {
    ASrc a{(const u16*)(ws + L1_O0), 1024, (const u16*)(ws + L1_O0), 1024, 1 << 30};
    gemm_phase(smem, a, (const u16*)(ws + W_OUT), MLAT, 1024, 1024, EpiResid{P->out, xctx, P->out, xctx, modv1 + 2 * 1024});
  }
  xcd_barrier(xbar);
  PM(16) norm_phase(P->out, xctx, MLAT, P->in[I_NMLP] + 1024, modv1, 3, 4, (u16*)(ws + L1_H));
  xcd_barrier(xbar);
  PM(17) {
    ASrc a{(const u16*)(ws + L1_H), 1024, (const u16*)(ws + L1_H), 1024, 1 << 30};
    gemm_phase(smem, a, (const u16*)(ws + W_1), MLAT, 4096, 1024, EpiRelu2{(u16*)(ws + L1_U)});
  }
  xcd_barrier(xbar);
  PM(18) {
    ASrc a{(const u16*)(ws + L1_U), 4096, (const u16*)(ws + L1_U), 4096, 1 << 30};
    gemm_phase(smem, a, (const u16*)(ws + W_2), MLAT, 1024, 4096, EpiResid{P->out, xctx, P->out, xctx, modv1 + 5 * 1024});
  }
  xcd_barrier(xbar);
  PM(19) final_norm_phase(P);
}

extern "C" void kernel_launch(void* const* d_in, const int* in_sizes, int n_in, void* d_out, int out_size, void* d_ws, size_t ws_size,
                              hipStream_t stream) {
  static int grid_blocks = 0;
  if (!grid_blocks) {
    int dev = 0, cus = 0, per_cu = 0;
    hipGetDevice(&dev);
    hipDeviceGetAttribute(&cus, hipDeviceAttributeMultiprocessorCount, dev);
    hipFuncSetAttribute((const void*)fwd_megakernel, hipFuncAttributeMaxDynamicSharedMemorySize, LDS_BYTES);
    hipOccupancyMaxActiveBlocksPerMultiprocessor(&per_cu, (const void*)fwd_megakernel, NTHR, LDS_BYTES);
    if (per_cu < 1) per_cu = 1;
    if (per_cu > 2) per_cu = 2;
    grid_blocks = cus * per_cu;
    if (ws_size < WS_NEED) fprintf(stderr, "kernel_launch: workspace too small: %zu < %zu\n", ws_size, (size_t)WS_NEED);
  }
  Params p{};
  for (int i = 0; i < 41; ++i) p.in[i] = (const float*)d_in[i];
  p.out = (float*)d_out;
  p.ws = (unsigned char*)d_ws;
  (void)hipMemsetAsync((unsigned char*)d_ws + OFF_SMALL + S_BAR, 0, XCD_BAR_WORDS * 4, stream);
  void* args[] = {&p};
  hipError_t e = hipLaunchCooperativeKernel((const void*)fwd_megakernel, dim3(grid_blocks), dim3(NTHR), args, LDS_BYTES, stream);
  if (e != hipSuccess) fprintf(stderr, "cooperative launch failed: %s (grid %d)\n", hipGetErrorString(e), grid_blocks);
}
```

```cpp
#include <hip/hip_runtime.h>
#include <hip/hip_cooperative_groups.h>
#include <stdint.h>
#include <stdio.h>
namespace cg = cooperative_groups;

typedef unsigned short u16;
typedef __attribute__((ext_vector_type(8))) short bf16x8;
typedef __attribute__((ext_vector_type(4))) float f32x4;

#define NTHR 256
#define MLAT 16384
#define MCTX 2048
#define MTOT 18432
#define LDS_BYTES 73728

constexpr size_t W_IN = 0, W_OUT = 8650752, W_1 = 10747904, W_2 = 19136512, SZ_W = 27525120;
constexpr size_t OFF_SMALL = SZ_W;
constexpr size_t S_MODV = 0;
constexpr size_t S_RNORM = 458752;
constexpr size_t S_BONUS = S_RNORM + 589824;
constexpr size_t S_H3 = S_BONUS + 589824;
constexpr size_t S_HNORM = S_H3 + 589824;
constexpr size_t S_EG = S_HNORM + 4096;
constexpr size_t S_BETA = S_EG + 1179648;
constexpr size_t S_PAB = S_BETA + 1179648;
constexpr size_t S_BAR = 6951936;
constexpr size_t SZ_SMALL = 8388608;
static_assert(S_PAB + 2359296 <= SZ_SMALL, "small");
constexpr size_t OFF_XCTX = OFF_SMALL + SZ_SMALL;
constexpr size_t OFF_A1 = OFF_XCTX + 8388608;
constexpr size_t OFF_FILT = OFF_A1;
constexpr size_t OFF_FILTC = OFF_FILT + 8388608;
constexpr size_t OFF_A0 = OFF_FILT + 9437184;
constexpr size_t SZ_T512 = (size_t)MTOT * 512 * 2;
constexpr size_t L0_H = OFF_A0;
constexpr size_t L0_PRW = L0_H + (size_t)MTOT * 1024 * 2;
constexpr size_t L0_PHY = L0_PRW + (size_t)MTOT * 1792 * 2;
constexpr size_t L0_S = L0_PHY + (size_t)MTOT * 1536 * 2;
constexpr size_t L0_X0C = L0_S + SZ_T512;
constexpr size_t L0_OM1 = L0_H, L0_G = L0_H + SZ_T512;
constexpr size_t L0_LR = L0_X0C + SZ_T512;
static_assert(L0_LR + (size_t)MTOT * 256 * 2 <= 268435456, "ws");
constexpr size_t W_LRW = W_IN + 6815744, W_LRA = W_LRW + 131072, W_LRG = W_LRA + 131072;
constexpr size_t L0_Y0 = L0_PHY, L0_Y1 = L0_PHY + SZ_T512, L0_HY = L0_PHY + 2 * SZ_T512;
constexpr size_t L0_U = L0_PRW;
static_assert(L0_X0C + SZ_T512 <= 268435456, "ws");
static_assert(L0_U + (size_t)MTOT * 4096 * 2 <= 268435456, "ws");
constexpr size_t DO_A0 = 0, DO_A1 = SZ_T512, DO_OM0 = 2 * SZ_T512;
constexpr size_t L1_H = OFF_A1;
constexpr size_t L1_PQKV = L1_H + (size_t)MTOT * 1024 * 2;
constexpr size_t L1_PZ = L1_PQKV + (size_t)MTOT * 3072 * 2;
constexpr size_t L1_O1 = L1_PZ + (size_t)MTOT * 1024 * 2;
constexpr size_t L1_O0 = L1_H;
constexpr size_t L1_U = L1_PQKV;
static_assert(L1_O1 + (size_t)MLAT * 1024 * 2 <= 268435456, "ws");
constexpr size_t WS_NEED = 268435456;

struct Params { const float* in[41]; float* out; unsigned char* ws; };
typedef const __attribute__((address_space(4))) Params* CP;
__device__ __forceinline__ CP launder(CP p) { asm volatile("" : "+s"(p)); return p; }

enum { I_X = 0, I_C, I_CTX, I_CCTX, I_ADAW, I_ADAB, I_NMIX, I_NMLP, I_W1, I_W2, I_FNORM, I_ABIN, I_ABOUT, I_MU, I_RW0, I_WUP,
       I_A0, I_AUP, I_GUP, I_KK, I_KA, I_RK, I_LNW, I_LNB, I_HCW, I_HCB, I_FW1, I_FB1, I_FW2, I_FB2, I_FW3, I_FB3, I_FW4,
       I_FREQ, I_SKIP, I_DNIN, I_DNCW, I_DNALOG, I_DNDT, I_DNNORM, I_DNOUT };

__device__ __forceinline__ u16 f2bf(float f) { unsigned u = __float_as_uint(f); u += 0x7fffu + ((u >> 16) & 1u); return (u16)(u >> 16); }
__device__ __forceinline__ float bf2f(u16 h) { return __uint_as_float(((unsigned)h) << 16); }
__device__ __forceinline__ unsigned pack2(float a, float b) { return (unsigned)f2bf(a) | ((unsigned)f2bf(b) << 16); }
__device__ __forceinline__ float sigmoidf_(float x) { return 1.f / (1.f + __expf(-x)); }
__device__ __forceinline__ float siluf_(float x) { return x / (1.f + __expf(-x)); }
__device__ __forceinline__ float softplusf_(float x) { return fmaxf(x, 0.f) + log1pf(__expf(-fabsf(x))); }
__device__ __forceinline__ float wave_sum(float v) {
  v += __int_as_float(__builtin_amdgcn_mov_dpp(__float_as_int(v), 0xB1, 0xF, 0xF, true));
  v += __int_as_float(__builtin_amdgcn_mov_dpp(__float_as_int(v), 0x4E, 0xF, 0xF, true));
  v += __int_as_float(__builtin_amdgcn_mov_dpp(__float_as_int(v), 0x141, 0xF, 0xF, true));
  v += __int_as_float(__builtin_amdgcn_mov_dpp(__float_as_int(v), 0x140, 0xF, 0xF, true));
  float a = __int_as_float(__builtin_amdgcn_readlane(__float_as_int(v), 0)), b = __int_as_float(__builtin_amdgcn_readlane(__float_as_int(v), 16));
  float c = __int_as_float(__builtin_amdgcn_readlane(__float_as_int(v), 32)), d = __int_as_float(__builtin_amdgcn_readlane(__float_as_int(v), 48));
  return (a + b) + (c + d);
}
typedef float v2f __attribute__((ext_vector_type(2)));
__device__ __forceinline__ float red8(float v) {
  v += __int_as_float(__builtin_amdgcn_mov_dpp(__float_as_int(v), 0xB1, 0xF, 0xF, true));
  v += __int_as_float(__builtin_amdgcn_mov_dpp(__float_as_int(v), 0x4E, 0xF, 0xF, true));
  v += __int_as_float(__builtin_amdgcn_mov_dpp(__float_as_int(v), 0x141, 0xF, 0xF, true));
  return v;
}
__device__ __forceinline__ float red16(float v) {
  v = red8(v);
  v += __int_as_float(__builtin_amdgcn_mov_dpp(__float_as_int(v), 0x140, 0xF, 0xF, true));
  return v;
}

#define RED16S(v) do { v += DPPF(v, 0xB1); v += DPPF(v, 0x4E); v += DPPF(v, 0x141); v += DPPF(v, 0x140); } while (0)
#define DPPF(v, ctrl) __int_as_float(__builtin_amdgcn_mov_dpp(__float_as_int(v), ctrl, 0xF, 0xF, true))
__device__ __forceinline__ void red16x2(v2f& a, v2f& b) {
  { v2f ta, tb; ta.x = DPPF(a.x, 0xB1); ta.y = DPPF(a.y, 0xB1); tb.x = DPPF(b.x, 0xB1); tb.y = DPPF(b.y, 0xB1); a += ta; b += tb; }
  { v2f ta, tb; ta.x = DPPF(a.x, 0x4E); ta.y = DPPF(a.y, 0x4E); tb.x = DPPF(b.x, 0x4E); tb.y = DPPF(b.y, 0x4E); a += ta; b += tb; }
  { v2f ta, tb; ta.x = DPPF(a.x, 0x141); ta.y = DPPF(a.y, 0x141); tb.x = DPPF(b.x, 0x141); tb.y = DPPF(b.y, 0x141); a += ta; b += tb; }
  { v2f ta, tb; ta.x = DPPF(a.x, 0x140); ta.y = DPPF(a.y, 0x140); tb.x = DPPF(b.x, 0x140); tb.y = DPPF(b.y, 0x140); a += ta; b += tb; }
}

#define XB_TMO      128
#define XB_XCNT(j)  (256  + 64 * (j))
#define XB_XSUB(j)  (1280 + 64 * (j))
#define XB_XGEN(j)  (2304 + 64 * (j))
#define XB_TOP      3328
#define XB_TOPGEN   3392
#define XCD_BAR_WORDS 3456
#define XB_SPIN_CAP (1u << 18)
#define LAS __attribute__((address_space(3)))

__device__ __forceinline__ unsigned xb_ld(unsigned* p)              { return __hip_atomic_load(p, __ATOMIC_RELAXED, __HIP_MEMORY_SCOPE_AGENT); }
__device__ __forceinline__ unsigned xb_add(unsigned* p, unsigned v) { return __hip_atomic_fetch_add(p, v, __ATOMIC_RELAXED, __HIP_MEMORY_SCOPE_AGENT); }
__device__ __forceinline__ unsigned xb_xcc_id() { return (unsigned)__builtin_amdgcn_s_getreg((3 << 11) | 20) & 0xFu; }
#define XB_SPIN(cond, bar) do { unsigned _sp = 0; while (cond) { __builtin_amdgcn_s_sleep(0);     \
    if ((++_sp & 255u) == 0u) { if (xb_ld(&(bar)[XB_TMO])) break; if (_sp > XB_SPIN_CAP) { atomicAdd(&(bar)[XB_TMO], 1u); break; } } } } while (0)

struct XcdBarrier {
    unsigned* bar; unsigned x;
    volatile LAS unsigned* st;
};

__device__ __forceinline__ XcdBarrier xcd_barrier_post(unsigned* bar, volatile LAS unsigned* st) {
    XcdBarrier b; b.bar = bar; b.x = xb_xcc_id(); b.st = st;
    if (threadIdx.x == 0) (void)xb_add(&bar[XB_XCNT(b.x)], 1u);
    return b;
}
__device__ __forceinline__ void xcd_barrier_complete(unsigned* bar, unsigned x, unsigned& nloc, unsigned& nx) {
    const unsigned G = gridDim.x * gridDim.y * gridDim.z;
    unsigned sum, cnt, mine, sp = 0u;
    for (;;) {
        sum = 0u; cnt = 0u; mine = 0u;
#pragma unroll
        for (unsigned j = 0; j < 16; ++j) { const unsigned c = xb_ld(&bar[XB_XCNT(j)]); sum += c; cnt += (c > 0u) ? 1u : 0u; mine = (j == x) ? c : mine; }
        if (sum == G) break;
        __builtin_amdgcn_s_sleep(1);
        if ((++sp & 255u) == 0u) { if (xb_ld(&bar[XB_TMO])) break; if (sp > XB_SPIN_CAP) { atomicAdd(&bar[XB_TMO], 1u); break; } }
    }
    nloc = mine > 0u ? mine : 1u; nx = cnt > 0u ? cnt : 1u;
}

__device__ __forceinline__ void xcd_barrier(const XcdBarrier& b) {
    asm volatile("s_waitcnt vmcnt(0)" ::: "memory");
    __syncthreads();
    if (threadIdx.x == 0) {
        unsigned* bar = b.bar;
        __builtin_amdgcn_s_waitcnt(0);
        unsigned nloc = b.st[0], nx = b.st[1];
        if (nloc == 0u) { xcd_barrier_complete(bar, b.x, nloc, nx); b.st[0] = nloc; b.st[1] = nx; }
        const unsigned old = xb_add(&bar[XB_XSUB(b.x)], 1u);
        const unsigned gen = old / nloc;
        if (old + 1u == (gen + 1u) * nloc) {
            __builtin_amdgcn_fence(__ATOMIC_RELEASE, "agent");
            asm volatile("s_waitcnt vmcnt(0)" ::: "memory");
            const unsigned og = xb_add(&bar[XB_TOP], 1u);
            const unsigned tg = og / nx;
            if (og + 1u == (tg + 1u) * nx) xb_add(&bar[XB_TOPGEN], 1u);
            else XB_SPIN(xb_ld(&bar[XB_TOPGEN]) == tg, bar);
            __builtin_amdgcn_fence(__ATOMIC_ACQUIRE, "agent");
            xb_add(&bar[XB_XGEN(b.x)], 1u);
            asm volatile("s_waitcnt vmcnt(0)" ::: "memory");
        } else {
            XB_SPIN(xb_ld(&bar[XB_XGEN(b.x)]) == gen, bar);
            __builtin_amdgcn_fence(__ATOMIC_ACQUIRE, "agent");
            asm volatile("s_waitcnt vmcnt(0)" ::: "memory");
        }
    }
    __syncthreads();
}


__device__ __forceinline__ float fma_s(float a, float b, float c) { float d; asm("v_fma_f32 %0, %1, %2, %3" : "=v"(d) : "v"(a), "v"(b), "v"(c)); return d; }
__device__ __forceinline__ float mul_s(float a, float b) { float d; asm("v_mul_f32 %0, %1, %2" : "=v"(d) : "v"(a), "v"(b)); return d; }
__device__ __forceinline__ void red16q(float& a, float& b, float& c, float& d) {
  asm("s_nop 1\n\t"
      "v_add_f32_dpp %0, %0, %0 quad_perm:[1,0,3,2] row_mask:0xf bank_mask:0xf bound_ctrl:1\n\t"
      "v_add_f32_dpp %1, %1, %1 quad_perm:[1,0,3,2] row_mask:0xf bank_mask:0xf bound_ctrl:1\n\t"
      "v_add_f32_dpp %2, %2, %2 quad_perm:[1,0,3,2] row_mask:0xf bank_mask:0xf bound_ctrl:1\n\t"
      "v_add_f32_dpp %3, %3, %3 quad_perm:[1,0,3,2] row_mask:0xf bank_mask:0xf bound_ctrl:1\n\t"
      "v_add_f32_dpp %0, %0, %0 quad_perm:[2,3,0,1] row_mask:0xf bank_mask:0xf bound_ctrl:1\n\t"
      "v_add_f32_dpp %1, %1, %1 quad_perm:[2,3,0,1] row_mask:0xf bank_mask:0xf bound_ctrl:1\n\t"
      "v_add_f32_dpp %2, %2, %2 quad_perm:[2,3,0,1] row_mask:0xf bank_mask:0xf bound_ctrl:1\n\t"
      "v_add_f32_dpp %3, %3, %3 quad_perm:[2,3,0,1] row_mask:0xf bank_mask:0xf bound_ctrl:1\n\t"
      "v_add_f32_dpp %0, %0, %0 row_half_mirror row_mask:0xf bank_mask:0xf bound_ctrl:1\n\t"
      "v_add_f32_dpp %1, %1, %1 row_half_mirror row_mask:0xf bank_mask:0xf bound_ctrl:1\n\t"
      "v_add_f32_dpp %2, %2, %2 row_half_mirror row_mask:0xf bank_mask:0xf bound_ctrl:1\n\t"
      "v_add_f32_dpp %3, %3, %3 row_half_mirror row_mask:0xf bank_mask:0xf bound_ctrl:1\n\t"
      "v_add_f32_dpp %0, %0, %0 row_mirror row_mask:0xf bank_mask:0xf bound_ctrl:1\n\t"
      "v_add_f32_dpp %1, %1, %1 row_mirror row_mask:0xf bank_mask:0xf bound_ctrl:1\n\t"
      "v_add_f32_dpp %2, %2, %2 row_mirror row_mask:0xf bank_mask:0xf bound_ctrl:1\n\t"
      "v_add_f32_dpp %3, %3, %3 row_mirror row_mask:0xf bank_mask:0xf bound_ctrl:1\n\t"
      "s_nop 1"
      : "+v"(a), "+v"(b), "+v"(c), "+v"(d));
}

__device__ __forceinline__ void red8d(float& a, float& b) {
  asm("s_nop 1\n\t"
      "v_add_f32_dpp %0, %0, %0 quad_perm:[1,0,3,2] row_mask:0xf bank_mask:0xf bound_ctrl:1\n\t"
      "v_add_f32_dpp %1, %1, %1 quad_perm:[1,0,3,2] row_mask:0xf bank_mask:0xf bound_ctrl:1\n\t"
      "s_nop 0\n\t"
      "v_add_f32_dpp %0, %0, %0 quad_perm:[2,3,0,1] row_mask:0xf bank_mask:0xf bound_ctrl:1\n\t"
      "v_add_f32_dpp %1, %1, %1 quad_perm:[2,3,0,1] row_mask:0xf bank_mask:0xf bound_ctrl:1\n\t"
      "s_nop 0\n\t"
      "v_add_f32_dpp %0, %0, %0 row_half_mirror row_mask:0xf bank_mask:0xf bound_ctrl:1\n\t"
      "v_add_f32_dpp %1, %1, %1 row_half_mirror row_mask:0xf bank_mask:0xf bound_ctrl:1\n\t"
      "s_nop 0"
      : "+v"(a), "+v"(b));
}

__device__ __forceinline__ void lds_barrier() {
  asm volatile("s_waitcnt lgkmcnt(0)" ::: "memory");
  __builtin_amdgcn_s_barrier();
  asm volatile("" ::: "memory");
}

#define LDSROW 64
struct ASrc { const u16* p1; int ld1; const u16* p2; int ld2; int ksplit; };

template <class Epi>
__device__ __forceinline__ void gemm_phase(unsigned char* smem_raw, ASrc a, const u16* __restrict__ Bt, int M, int N, int K, Epi epi) {
  u16* sA = (u16*)smem_raw;
  u16* sB = sA + 2 * 128 * LDSROW;
  const int tid = threadIdx.x, lane = tid & 63, wid = tid >> 6;
  const int wr = wid >> 1, wc = wid & 1, fr = lane & 15, fq = lane >> 4;
  const int Mt = M / 128, Nt = N / 128, nk = K / 64;
  const int lrow = tid >> 3, lkc = tid & 7;
  const int wsw = lkc ^ ((lrow >> 1) & 7);
  const int rsw = fq ^ (fr >> 1);
  const int nx = (gridDim.x & 7) ? 1 : 8;
  const int xcd = (nx == 8) ? (blockIdx.x & 7) : 0, lb = (nx == 8) ? (blockIdx.x >> 3) : blockIdx.x, lstep = gridDim.x / nx;
  const int tm0 = (Mt * xcd) / nx, mh = (Mt * (xcd + 1)) / nx - tm0;
  for (int tl = lb; tl < mh * Nt; tl += lstep) {
    const int pn = tl / (mh * 8), rem = tl - pn * (mh * 8);
    const int wp = min(8, Nt - pn * 8);
    const int tm = tm0 + rem / wp, tn = pn * 8 + rem % wp;
    f32x4 acc[4][4];
#pragma unroll
    for (int i = 0; i < 4; ++i)
#pragma unroll
      for (int j = 0; j < 4; ++j) acc[i][j] = (f32x4){0.f, 0.f, 0.f, 0.f};
    auto gissue = [&](int kt, int buf) {
      const int k0 = kt * 64;
      const u16* ap; int lda;
      if (k0 < a.ksplit) { ap = a.p1 + k0; lda = a.ld1; } else { ap = a.p2 + (k0 - a.ksplit); lda = a.ld2; }
#pragma unroll
      for (int i = 0; i < 4; ++i) {
        const int r = lrow + i * 32;
        __builtin_amdgcn_global_load_lds((const unsigned*)(ap + (size_t)(tm * 128 + r) * lda + wsw * 8),
                                         (LAS unsigned*)(sA + buf * 128 * LDSROW + r * LDSROW + lkc * 8), 16, 0, 0);
        __builtin_amdgcn_global_load_lds((const unsigned*)(Bt + (size_t)(tn * 128 + r) * K + k0 + wsw * 8),
                                         (LAS unsigned*)(sB + buf * 128 * LDSROW + r * LDSROW + lkc * 8), 16, 0, 0);
      }
    };
    gissue(0, 0);
    asm volatile("s_waitcnt vmcnt(0)" ::: "memory");
    __syncthreads();
    for (int kt = 0; kt < nk; ++kt) {
      const int buf = kt & 1;
      if (kt + 1 < nk) gissue(kt + 1, buf ^ 1);
      const u16* pa = sA + buf * 128 * LDSROW + (wr * 64 + fr) * LDSROW;
      const u16* pb = sB + buf * 128 * LDSROW + (wc * 64 + fr) * LDSROW;
      bf16x8 af[2][4], bfr[2][4];
#pragma unroll
      for (int ks = 0; ks < 2; ++ks)
#pragma unroll
        for (int i = 0; i < 4; ++i) {
          af[ks][i] = *(const bf16x8*)(pa + i * 16 * LDSROW + ((rsw ^ (ks * 4)) * 8));
          bfr[ks][i] = *(const bf16x8*)(pb + i * 16 * LDSROW + ((rsw ^ (ks * 4)) * 8));
        }
      __builtin_amdgcn_s_setprio(1);
#pragma unroll
      for (int ks = 0; ks < 2; ++ks)
#pragma unroll
        for (int i = 0; i < 4; ++i)
#pragma unroll
          for (int j = 0; j < 4; ++j)
            acc[i][j] = __builtin_amdgcn_mfma_f32_16x16x32_bf16(bfr[ks][j], af[ks][i], acc[i][j], 0, 0, 0);
      __builtin_amdgcn_s_setprio(0);
      asm volatile("s_waitcnt vmcnt(0)" ::: "memory");
      __syncthreads();
    }
#pragma unroll
    for (int i = 0; i < 4; ++i)
#pragma unroll
      for (int j = 0; j < 4; ++j)
        epi(tm * 128 + wr * 64 + i * 16 + fr, tn * 128 + wc * 64 + j * 16 + fq * 4, acc[i][j]);
  }
}

struct EpiInProj0 {
  u16* prw; u16* phy;
  __device__ __forceinline__ void operator()(int row, int col, f32x4 v) const {
    uint2 pk = make_uint2(pack2(v[0], v[1]), pack2(v[2], v[3]));
    if (col < 1792) *(uint2*)(prw + (size_t)row * 1792 + col) = pk;
    else *(uint2*)(phy + (size_t)row * 1536 + (col - 1792)) = pk;
  }
};
struct EpiInProj1 {
  u16* pqkv; u16* pz; float* pab; u16* halo;
  __device__ __forceinline__ void operator()(int row, int col, f32x4 v) const {
    if (col < 4096) {
      uint2 pk = make_uint2(pack2(v[0], v[1]), pack2(v[2], v[3]));
      if (col < 3072) {
        *(uint2*)(pqkv + (size_t)row * 3072 + col) = pk;
        const int rl = row & 127;
        if (rl == 0 || rl == 127) *(uint2*)(halo + (size_t)((row >> 7) * 2 + (rl ? 1 : 0)) * 3072 + col) = pk;
      }
      else *(uint2*)(pz + (size_t)row * 1024 + (col - 3072)) = pk;
    } else if (col < 4128) {
      *(float4*)(pab + (size_t)row * 32 + (col - 4096)) = make_float4(v[0], v[1], v[2], v[3]);
    }
  }
};
struct EpiRelu2 {
  u16* u;
  __device__ __forceinline__ void operator()(int row, int col, f32x4 v) const {
    float a = fmaxf(v[0], 0.f), b = fmaxf(v[1], 0.f), c = fmaxf(v[2], 0.f), d = fmaxf(v[3], 0.f);
    *(uint2*)(u + (size_t)row * 4096 + col) = make_uint2(pack2(a * a, b * b), pack2(c * c, d * d));
  }
};
struct EpiResid {
  const float* xin_lat; const float* xin_ctx; float* xout_lat; float* xout_ctx; const float* modv;
  __device__ __forceinline__ void operator()(int row, int col, f32x4 v) const {
    const float* xi; float* xo; int mr;
    if (row < MLAT) { mr = row >> 11; xi = xin_lat + (size_t)row * 1024; xo = xout_lat + (size_t)row * 1024; }
    else { mr = 8; xi = xin_ctx + (size_t)(row - MLAT) * 1024; xo = xout_ctx + (size_t)(row - MLAT) * 1024; }
    float4 x = *(const float4*)(xi + col);
    float4 m = *(const float4*)(modv + mr * 6144 + col);
    *(float4*)(xo + col) = make_float4(x.x + m.x * v[0], x.y + m.y * v[1], x.z + m.z * v[2], x.w + m.w * v[3]);
  }
};

__device__ __forceinline__ void norm_phase(const float* xlat, const float* xctx, int nrows, const float* nw, const float* modl, int shiftc, int scalec, u16* h) {
  const int lane = threadIdx.x & 63, wid = threadIdx.x >> 6;
  for (int row = blockIdx.x * 4 + wid; row < nrows; row += gridDim.x * 4) {
    const float* src; int mr;
    if (row < MLAT) { src = xlat + (size_t)row * 1024; mr = row >> 11; } else { src = xctx + (size_t)(row - MLAT) * 1024; mr = 8; }
    float4 v[4]; float ss = 0.f;
#pragma unroll
    for (int i = 0; i < 4; ++i) { v[i] = *(const float4*)(src + (i * 64 + lane) * 4); ss += v[i].x * v[i].x + v[i].y * v[i].y + v[i].z * v[i].z + v[i].w * v[i].w; }
    ss = wave_sum(ss);
    const float rs = rsqrtf(ss * (1.f / 1024.f) + 1e-6f);
    const float* sh = modl + mr * 6144 + shiftc * 1024; const float* sc = modl + mr * 6144 + scalec * 1024;
#pragma unroll
    for (int i = 0; i < 4; ++i) {
      int c = (i * 64 + lane) * 4;
      float4 w = *(const float4*)(nw + c), s = *(const float4*)(sh + c), g = *(const float4*)(sc + c);
      float a = v[i].x * rs * w.x * (1.f + g.x) + s.x, b = v[i].y * rs * w.y * (1.f + g.y) + s.y;
      float cc = v[i].z * rs * w.z * (1.f + g.z) + s.z, d = v[i].w * rs * w.w * (1.f + g.w) + s.w;
      *(uint2*)(h + (size_t)row * 1024 + c) = make_uint2(pack2(a, b), pack2(cc, d));
    }
  }
}

__device__ __forceinline__ void wconv_item(float* tile  , const float* __restrict__ src, int K, int N, int Npad, u16* dst, int item) {
  const int tid = threadIdx.x;
  const int ntn = Npad / 64;
  const int tk = item / ntn, tn = item % ntn;
#pragma unroll
  for (int i = 0; i < 16; ++i) {
    int k = i * 4 + (tid >> 6), n = tid & 63;
    int gn = tn * 64 + n;
    tile[k * 65 + n] = (gn < N) ? src[(size_t)(tk * 64 + k) * N + gn] : 0.f;
  }
  __syncthreads();
#pragma unroll
  for (int i = 0; i < 2; ++i) {
    int c = tid + i * 256, n = c >> 3, kg = c & 7;
    unsigned p[4];
#pragma unroll
    for (int j = 0; j < 4; ++j) p[j] = pack2(tile[(kg * 8 + 2 * j) * 65 + n], tile[(kg * 8 + 2 * j + 1) * 65 + n]);
    *(uint4*)(dst + (size_t)(tn * 64 + n) * K + tk * 64 + kg * 8) = make_uint4(p[0], p[1], p[2], p[3]);
  }
  __syncthreads();
}
__device__ __forceinline__ void wconv_layer(float* tile, CP P, int layer, int gstart, int gstride) {
  unsigned char* ws = P->ws;
  const float* s_in; int n_in, np_in; const float* s_out;
  if (layer == 0) { s_in = P->in[I_ABIN]; n_in = 3328; np_in = 3328; s_out = P->in[I_ABOUT]; }
  else { s_in = P->in[I_DNIN]; n_in = 4128; np_in = 4224; s_out = P->in[I_DNOUT]; }
  const float* s_w1 = P->in[I_W1] + (size_t)layer * 1024 * 4096;
  const float* s_w2 = P->in[I_W2] + (size_t)layer * 4096 * 1024;
  const int n0 = 16 * (np_in / 64), n1 = 16 * 16, n2 = 16 * 64, n3 = 64 * 16;
  const int n4 = (layer == 0) ? 48 : 0;
  for (int it = gstart; it < n0 + n1 + n2 + n3 + n4; it += gstride) {
    if (it >= n0 + n1 + n2 + n3) {
      const int q = it - (n0 + n1 + n2 + n3);
      if (q < 16) wconv_item(tile, P->in[I_WUP] + (size_t)(q >> 3) * 64 * 512, 64, 512, 512, (u16*)(ws + W_LRW) + (size_t)(q >> 3) * 512 * 64, q & 7);
      else if (q < 32) wconv_item(tile, P->in[I_AUP] + (size_t)((q - 16) >> 3) * 64 * 512, 64, 512, 512, (u16*)(ws + W_LRA) + (size_t)((q - 16) >> 3) * 512 * 64, q & 7);
      else wconv_item(tile, P->in[I_GUP], 128, 512, 512, (u16*)(ws + W_LRG), q - 32);
    }
    else if (it < n0) wconv_item(tile, s_in, 1024, n_in, np_in, (u16*)(ws + W_IN), it);
    else if (it < n0 + n1) wconv_item(tile, s_out, 1024, 1024, 1024, (u16*)(ws + W_OUT), it - n0);
    else if (it < n0 + n1 + n2) wconv_item(tile, s_w1, 1024, 4096, 4096, (u16*)(ws + W_1), it - n0 - n1);
    else wconv_item(tile, s_w2, 4096, 1024, 1024, (u16*)(ws + W_2), it - n0 - n1 - n2);
  }
}

__device__ __forceinline__ void modv_item(float* lds, CP P, int item) {
  const int tid = threadIdx.x;
  const int l = item / 192, n0 = (item % 192) * 32;
  float* sc = lds;
  float* red = lds + 9 * 1024;
  for (int e = tid; e < 9 * 1024; e += NTHR) {
    int r = e >> 10, k = e & 1023;
    float cv = (r < 8) ? P->in[I_C][r * 1024 + k] : P->in[I_CCTX][k];
    sc[e] = siluf_(cv);
  }
  __syncthreads();
  const int col = tid & 31, kp = tid >> 5;
  const float* w = P->in[I_ADAW] + (size_t)l * 1024 * 6144 + n0 + col;
  float acc[9];
#pragma unroll
  for (int r = 0; r < 9; ++r) acc[r] = 0.f;
#pragma unroll 4
  for (int k = kp * 128; k < kp * 128 + 128; k += 4) {
    float w0 = w[(size_t)k * 6144], w1 = w[(size_t)(k + 1) * 6144], w2 = w[(size_t)(k + 2) * 6144], w3 = w[(size_t)(k + 3) * 6144];
#pragma unroll
    for (int r = 0; r < 9; ++r) {
      float4 s = *(const float4*)(sc + r * 1024 + k);
      acc[r] += s.x * w0 + s.y * w1 + s.z * w2 + s.w * w3;
    }
  }
#pragma unroll
  for (int r = 0; r < 9; ++r) red[(kp * 9 + r) * 32 + col] = acc[r];
  __syncthreads();
  float* modv = (float*)(P->ws + OFF_SMALL + S_MODV);
  for (int e = tid; e < 9 * 32; e += NTHR) {
    int r = e >> 5, c = e & 31;
    float s = 0.f;
#pragma unroll
    for (int q = 0; q < 8; ++q) s += red[(q * 9 + r) * 32 + c];
    modv[(size_t)l * 9 * 6144 + r * 6144 + n0 + c] = s + P->in[I_ADAB][l * 6144 + n0 + c];
  }
  __syncthreads();
}

__device__ __forceinline__ void h3_item(float* lds, CP P, int item) {
  const int tid = threadIdx.x, p = tid >> 6, j = tid & 63;
  int L, pos, obase;
  if (item < 512) { L = 2048; pos = item * 4 + p; obase = 0; } else { L = 256; pos = (item - 512) * 4 + p; obase = 2048; }
  float* z = lds;
  float* ha = lds + 256;
  float* hb = lds + 512;
  if (j < 33) {
    float val;
    if (j == 0) val = (float)pos / (float)(L - 1);
    else {
      int bi = (j - 1) & 15;
      float f = 1e-4f + (float)bi * ((15.f - 1e-4f) / 15.f);
      float w = 6.283185307179586f * (float)pos / (float)L;
      float ang = f * w;
      val = (j <= 16) ? cosf(ang) : -sinf(ang);
    }
    z[p * 64 + j] = val;
  }
  __syncthreads();
  const float fq = P->in[I_FREQ][j];
  {
    float s = P->in[I_FB1][j];

#pragma unroll 4
    for (int i = 0; i < 33; ++i) s += z[p * 64 + i] * P->in[I_FW1][i * 64 + j];
    ha[p * 64 + j] = sinf(fq * s);
  }
  __syncthreads();
  {
    float s = P->in[I_FB2][j];

#pragma unroll 4
    for (int i = 0; i < 64; ++i) s += ha[p * 64 + i] * P->in[I_FW2][i * 64 + j];
    hb[p * 64 + j] = sinf(fq * s);
  }
  __syncthreads();
  {
    float s = P->in[I_FB3][j];

#pragma unroll 4
    for (int i = 0; i < 64; ++i) s += hb[p * 64 + i] * P->in[I_FW3][i * 64 + j];
    float* H3 = (float*)(P->ws + OFF_SMALL + S_H3);
    H3[(size_t)(obase + pos) * 64 + j] = sinf(fq * s);
  }
  __syncthreads();
}

__device__ __forceinline__ void kun_item(float* lds, CP P, int item) {
  const int tid = threadIdx.x;
  int L, pos0, hbase, seq; float* filt;
  if (item < 256) { L = 2048; pos0 = item * 8; hbase = 0; seq = 0; filt = (float*)(P->ws + OFF_FILT); }
  else { L = 256; pos0 = (item - 256) * 8; hbase = 2048; seq = 1; filt = (float*)(P->ws + OFF_FILTC); }
  const float* H3 = (const float*)(P->ws + OFF_SMALL + S_H3);
  float* hs = lds;
  for (int e = tid; e < 512; e += NTHR) { int p = e >> 6, i = e & 63; hs[i * 8 + p] = H3[(size_t)(hbase + pos0 + p) * 64 + i]; }
  __syncthreads();
  float acc[4][8];
#pragma unroll
  for (int q = 0; q < 4; ++q)
#pragma unroll
    for (int p = 0; p < 8; ++p) acc[q][p] = 0.f;
  const float* w4 = P->in[I_FW4];
  for (int i = 0; i < 64; ++i) {
    float4 h0 = *(const float4*)(hs + i * 8), h1 = *(const float4*)(hs + i * 8 + 4);
#pragma unroll
    for (int q = 0; q < 4; ++q) {
      float w = w4[i * 1024 + tid + q * 256];
      acc[q][0] += h0.x * w; acc[q][1] += h0.y * w; acc[q][2] += h0.z * w; acc[q][3] += h0.w * w;
      acc[q][4] += h1.x * w; acc[q][5] += h1.y * w; acc[q][6] += h1.z * w; acc[q][7] += h1.w * w;
    }
  }
  float* hnorm = (float*)(P->ws + OFF_SMALL + S_HNORM);
  const float lo = -3.0701134573253945f, hi = -15.350567286626973f;
#pragma unroll
  for (int q = 0; q < 4; ++q) {
    int col = tid + q * 256, half = col >> 9, c = col & 511;
    float delta = fabsf(lo + (hi - lo) * ((float)c / 511.f));
    float asum = 0.f;
#pragma unroll
    for (int p = 0; p < 8; ++p) {
      int j = pos0 + p;
      float t = (float)j / (float)(L - 1);
      float val = acc[q][p] * __expf(-t * delta);
      if (half == 0) { filt[(size_t)c * (2 * L) + (j + L - 1)] = val; asum += fabsf(val); }
      else if (j >= 1) { filt[(size_t)c * (2 * L) + (L - 1 - j)] = val; asum += fabsf(val); }
    }
    atomicAdd(&hnorm[seq * 512 + c], asum);
  }
  __syncthreads();
}

__device__ __forceinline__ void seq_of_row(int row, int& sstart, int& slen) {
  if (row < MLAT) { sstart = row & ~2047; slen = 2048; } else { sstart = MLAT + ((row - MLAT) & ~255); slen = 256; }
}

__device__ __forceinline__ void lrprep_item(CP P, int item) {
  const int tid = threadIdx.x, lane = tid & 63;
  const int row0 = item * 16;
  int sstart, slen; seq_of_row(row0, sstart, slen);
  const int send = sstart + slen;
  unsigned char* ws = P->ws;
  const u16* prw = (const u16*)(ws + L0_PRW);
  u16* LR = (u16*)(ws + L0_LR);
  float* RN = (float*)(ws + OFF_SMALL + S_RNORM);
  {
    const int col = 1536 + tid;
    const float mu = P->in[I_MU][col];
    u16 rv[18];
#pragma unroll
    for (int t = 0; t < 18; ++t) { int rr = row0 - 1 + t; rr = rr < sstart ? sstart : (rr >= send ? send - 1 : rr); rv[t] = prw[(size_t)rr * 1792 + col]; }
#pragma unroll
    for (int t = 0; t < 16; ++t) {
      float prev = (row0 + t - 1 >= sstart) ? bf2f(rv[t]) : 0.f, cur = bf2f(rv[t + 1]), nxt = (row0 + t + 1 < send) ? bf2f(rv[t + 2]) : 0.f;
      float s = cur + mu * (0.5f * (prev + nxt) - cur);
      float o = (tid < 64) ? tanhf(s) : ((tid < 128) ? s : sigmoidf_(s));
      LR[(size_t)(row0 + t) * 256 + tid] = f2bf(o);
    }
  }
#pragma unroll
  for (int jj = 0; jj < 2; ++jj) {
    const int j = tid + jj * 256, head = j >> 6;
    const float muk = P->in[I_MU][512 + j], kkk = P->in[I_KK][j];
    u16 kv[18];
#pragma unroll
    for (int t = 0; t < 18; ++t) { int rr = row0 - 1 + t; rr = rr < sstart ? sstart : (rr >= send ? send - 1 : rr); kv[t] = prw[(size_t)rr * 1792 + 512 + j]; }
#pragma unroll
    for (int t = 0; t < 16; ++t) {
      float kp = (row0 + t - 1 >= sstart) ? bf2f(kv[t]) : 0.f, kc = bf2f(kv[t + 1]), kn = (row0 + t + 1 < send) ? bf2f(kv[t + 2]) : 0.f;
      float ks = kc + muk * (0.5f * (kp + kn) - kc);
      float kq = ks * kkk; kq = wave_sum(kq * kq);
      if (lane == 0) RN[(size_t)(row0 + t) * 8 + head] = rsqrtf(kq + 1e-6f);
    }
  }
}

struct EpiLrW {
  u16* om0; u16* om1; const float* w0;
  __device__ __forceinline__ void operator()(int row, int col, f32x4 v) const {
    float o[4];
#pragma unroll
    for (int e = 0; e < 4; ++e) {
      float z = w0[col + e] + v[e];
      float wlog = -softplusf_(-z) - 0.5f;
      o[e] = -expm1f(-__expf(wlog));
    }
    u16* dst = (col < 512) ? om0 : om1;
    *(uint2*)(dst + (size_t)row * 512 + (col & 511)) = make_uint2(pack2(o[0], o[1]), pack2(o[2], o[3]));
  }
};
struct EpiLrA {
  u16* a0; u16* a1; const float* b0;
  __device__ __forceinline__ void operator()(int row, int col, f32x4 v) const {
    float o[4];
#pragma unroll
    for (int e = 0; e < 4; ++e) o[e] = sigmoidf_(b0[col + e] + v[e]);
    u16* dst = (col < 512) ? a0 : a1;
    *(uint2*)(dst + (size_t)row * 512 + (col & 511)) = make_uint2(pack2(o[0], o[1]), pack2(o[2], o[3]));
  }
};
struct EpiLrG {
  u16* g;
  __device__ __forceinline__ void operator()(int row, int col, f32x4 v) const {
    *(uint2*)(g + (size_t)row * 512 + col) = make_uint2(pack2(v[0], v[1]), pack2(v[2], v[3]));
  }
};

__device__ __forceinline__ void hyprep_item(CP P, int item) {
  const int tid = threadIdx.x;
  const int row0 = item * 16;
  int sstart, slen; seq_of_row(row0, sstart, slen);
  const int send = sstart + slen;
  const u16* phy = (const u16*)(P->ws + L0_PHY);
  u16* S = (u16*)(P->ws + L0_S); u16* X0 = (u16*)(P->ws + L0_X0C);
  const float* cw = P->in[I_HCW]; const float* cb = P->in[I_HCB];
  for (int cc = 0; cc < 2; ++cc) {
    const int c = tid + cc * 256;
    float w[3][3], bsv[3], pv[3], cv[3];
#pragma unroll
    for (int g = 0; g < 3; ++g) {
      int col = g * 512 + c;
      w[g][0] = cw[col]; w[g][1] = cw[1536 + col]; w[g][2] = cw[3072 + col]; bsv[g] = cb[col];
      pv[g] = (row0 - 1 >= sstart) ? bf2f(phy[(size_t)(row0 - 1) * 1536 + col]) : 0.f;
      cv[g] = bf2f(phy[(size_t)row0 * 1536 + col]);
    }
    unsigned sp[8];
#pragma unroll
    for (int t = 0; t < 16; ++t) {
      int rn = row0 + t + 1; float o[3];
#pragma unroll
      for (int g = 0; g < 3; ++g) {
        float nx = (rn < send) ? bf2f(phy[(size_t)rn * 1536 + g * 512 + c]) : 0.f;
        o[g] = w[g][0] * pv[g] + w[g][1] * cv[g] + w[g][2] * nx + bsv[g];
        pv[g] = cv[g]; cv[g] = nx;
      }
      const unsigned sb = f2bf(o[1] * o[2]);
      if (t & 1) sp[t >> 1] |= sb << 16; else sp[t >> 1] = sb;
      X0[(size_t)(row0 + t) * 512 + c] = f2bf(o[0]);
    }
    *(uint4*)(S + (size_t)c * MTOT + row0) = make_uint4(sp[0], sp[1], sp[2], sp[3]);
    *(uint4*)(S + (size_t)c * MTOT + row0 + 8) = make_uint4(sp[4], sp[5], sp[6], sp[7]);
  }
}

__device__ __forceinline__ void rwscan_item(float* lds, CP P, int item) {
  const int tid = threadIdx.x;
  const int half = item & 1, dir = (item >> 1) & 1, h = (item >> 2) & 7, b = item >> 5;
  const int kq = tid & 7, rl = tid >> 3;
  unsigned char* ws = P->ws;
  const u16* prw = (const u16*)(ws + L0_PRW);
  const u16* Ad = (const u16*)((unsigned char*)P->out + (dir ? DO_A1 : DO_A0));
  const u16* OMd = dir ? (const u16*)(ws + L0_OM1) : (const u16*)((unsigned char*)P->out + DO_OM0);
  const float* RN = (const float*)(ws + OFF_SMALL + S_RNORM);
  u16* Y = (u16*)(ws + (dir ? L0_Y1 : L0_Y0));
  const int SSTR = 352, BUFSZ = 16 * 352;
  float* cst = lds + 2 * BUFSZ;
  __syncthreads();
  if (tid < 64) {
    const int cj = h * 64 + tid;
    cst[tid] = P->in[I_MU][cj]; cst[64 + tid] = P->in[I_MU][512 + cj]; cst[128 + tid] = P->in[I_KK][cj]; cst[192 + tid] = P->in[I_KA][cj];
    if (tid < 32) cst[256 + tid] = P->in[I_MU][1024 + h * 64 + half * 32 + tid];
  }
  const int sst = tid >> 4, sc4 = tid & 15;
  const int j0 = h * 64 + sc4 * 4;
  const int cv0 = 1024 + h * 64 + half * 32 + sc4 * 2;
  float sx[8];
#pragma unroll
  for (int j = 0; j < 8; ++j) sx[j] = 0.f;
  for (int seq = 0; seq < 2; ++seq) {
    const int Ls = seq ? 2048 : 256;
    const int rowbase = seq ? b * 2048 : MLAT + b * 256;
    const int nchunk = Ls / 16;
    uint2 R0, R1, R2, K0, K1, K2, AA, OO; unsigned V0, V1, V2; float rn = 0.f; bool hp = false, hn = false;
    auto gl = [&](int c) {
      int i = c * 16 + sst; int t = dir ? (Ls - 1 - i) : i; size_t row = rowbase + t;
      hp = t > 0; hn = t < Ls - 1;
      const size_t rp = hp ? row - 1 : row, rx = hn ? row + 1 : row;
      const u16* p = prw + row * 1792; const u16* pp = prw + rp * 1792; const u16* px = prw + rx * 1792;
      R1 = *(const uint2*)(p + j0); K1 = *(const uint2*)(p + 512 + j0);
      R0 = *(const uint2*)(pp + j0); K0 = *(const uint2*)(pp + 512 + j0);
      R2 = *(const uint2*)(px + j0); K2 = *(const uint2*)(px + 512 + j0);
      AA = *(const uint2*)(Ad + row * 512 + j0); OO = *(const uint2*)(OMd + row * 512 + j0);
      rn = RN[row * 8 + h];
      V1 = *(const unsigned*)(p + cv0); V0 = *(const unsigned*)(pp + cv0); V2 = *(const unsigned*)(px + cv0);
    };
    auto sw = [&](int buf) {
      float* sp = lds + buf * BUFSZ + sst * SSTR;
      const float fp = hp ? 1.f : 0.f, fn = hn ? 1.f : 0.f;
      const unsigned r0[2] = {R0.x, R0.y}, r1[2] = {R1.x, R1.y}, r2[2] = {R2.x, R2.y};
      const unsigned k0[2] = {K0.x, K0.y}, k1[2] = {K1.x, K1.y}, k2[2] = {K2.x, K2.y};
      const unsigned aa[2] = {AA.x, AA.y}, oo[2] = {OO.x, OO.y};
      const float4 mur4 = *(const float4*)(cst + sc4 * 4), muk4 = *(const float4*)(cst + 64 + sc4 * 4);
      const float4 kkk4 = *(const float4*)(cst + 128 + sc4 * 4), ka4 = *(const float4*)(cst + 192 + sc4 * 4);
      const float mur[4] = {mur4.x, mur4.y, mur4.z, mur4.w}, muk[4] = {muk4.x, muk4.y, muk4.z, muk4.w};
      const float kkk[4] = {kkk4.x, kkk4.y, kkk4.z, kkk4.w}, ka[4] = {ka4.x, ka4.y, ka4.z, ka4.w};
      float okk[4], ow[4], ob[4], okd[4], orr[4];
#pragma unroll
      for (int e = 0; e < 4; ++e) {
        const int q = e >> 1, sh = (e & 1) ? 0 : 16;
        auto ex = [&](unsigned u) { return __uint_as_float((u << sh) & 0xffff0000u); };
        float rc = ex(r1[q]), kc = ex(k1[q]);
        float rs = rc + mur[e] * (0.5f * (fp * ex(r0[q]) + fn * ex(r2[q])) - rc);
        float ks = kc + muk[e] * (0.5f * (fp * ex(k0[q]) + fn * ex(k2[q])) - kc);
        float a = ex(aa[q]), om = ex(oo[q]);
        float kk = ks * kkk[e] * rn;
        okk[e] = kk; ow[e] = 1.f - om; ob[e] = a * kk; okd[e] = ks * (1.f + (a - 1.f) * ka[e]); orr[e] = rs;
      }
      *(float4*)(sp + sc4 * 4) = make_float4(okk[0], okk[1], okk[2], okk[3]);
      *(float4*)(sp + 64 + sc4 * 4) = make_float4(ow[0], ow[1], ow[2], ow[3]);
      *(float4*)(sp + 128 + sc4 * 4) = make_float4(ob[0], ob[1], ob[2], ob[3]);
      *(float4*)(sp + 192 + sc4 * 4) = make_float4(okd[0], okd[1], okd[2], okd[3]);
      *(float4*)(sp + 256 + sc4 * 4) = make_float4(orr[0], orr[1], orr[2], orr[3]);
      {
        const float2 muv2 = *(const float2*)(cst + 256 + sc4 * 2);
        float va = __uint_as_float(V1 << 16), vb = __uint_as_float(V1 & 0xffff0000u);
        float o0 = va + muv2.x * (0.5f * (fp * __uint_as_float(V0 << 16) + fn * __uint_as_float(V2 << 16)) - va);
        float o1 = vb + muv2.y * (0.5f * (fp * __uint_as_float(V0 & 0xffff0000u) + fn * __uint_as_float(V2 & 0xffff0000u)) - vb);
        *(float2*)(sp + 320 + sc4 * 2) = make_float2(o0, o1);
      }
    };
    gl(0);
    __syncthreads();
    sw(0);
    __syncthreads();
    for (int c = 0; c < nchunk; ++c) {
      const int buf = c & 1;
      if (c + 1 < nchunk) gl(c + 1);
      float ykA = 0.f, ykB = 0.f;
      float4 rp0 = make_float4(0.f, 0.f, 0.f, 0.f), rp1 = make_float4(0.f, 0.f, 0.f, 0.f);
#pragma unroll
      for (int st = 0; st < 16; ++st) {
        const float* sp = lds + buf * BUFSZ + st * SSTR + kq * 8;
        const float4 k0 = *(const float4*)(sp), k1 = *(const float4*)(sp + 4);
        const float4 w0 = *(const float4*)(sp + 64), w1 = *(const float4*)(sp + 68);
        const float4 b0 = *(const float4*)(sp + 128), b1 = *(const float4*)(sp + 132);
        const float4 d0 = *(const float4*)(sp + 192), d1 = *(const float4*)(sp + 196);
        const float4 r0 = *(const float4*)(sp + 256), r1 = *(const float4*)(sp + 260);
        const float vv = lds[buf * BUFSZ + st * SSTR + 320 + rl];
        float pa = ((sx[0] * k0.x + sx[1] * k0.y) + (sx[2] * k0.z + sx[3] * k0.w)) + ((sx[4] * k1.x + sx[5] * k1.y) + (sx[6] * k1.z + sx[7] * k1.w));
        float py = ((sx[0] * rp0.x + sx[1] * rp0.y) + (sx[2] * rp0.z + sx[3] * rp0.w)) + ((sx[4] * rp1.x + sx[5] * rp1.y) + (sx[6] * rp1.z + sx[7] * rp1.w));
        red8d(pa, py);
        if (st > 0) { const int pv = st - 1; if (pv < 8) ykA = (kq == pv) ? py : ykA; else ykB = (kq == pv - 8) ? py : ykB; }
        const float sa = -pa;
        sx[0] = sx[0] * w0.x + (sa * b0.x + vv * d0.x); sx[1] = sx[1] * w0.y + (sa * b0.y + vv * d0.y);
        sx[2] = sx[2] * w0.z + (sa * b0.z + vv * d0.z); sx[3] = sx[3] * w0.w + (sa * b0.w + vv * d0.w);
        sx[4] = sx[4] * w1.x + (sa * b1.x + vv * d1.x); sx[5] = sx[5] * w1.y + (sa * b1.y + vv * d1.y);
        sx[6] = sx[6] * w1.z + (sa * b1.z + vv * d1.z); sx[7] = sx[7] * w1.w + (sa * b1.w + vv * d1.w);
        rp0 = r0; rp1 = r1;
      }
      {
        float py = ((sx[0] * rp0.x + sx[1] * rp0.y) + (sx[2] * rp0.z + sx[3] * rp0.w)) + ((sx[4] * rp1.x + sx[5] * rp1.y) + (sx[6] * rp1.z + sx[7] * rp1.w));
        float du = 0.f;
        red8d(py, du);
        ykB = (kq == 7) ? py : ykB;
      }
      {
        int i = c * 16 + kq; int t = dir ? (Ls - 1 - i) : i;
        Y[(size_t)(rowbase + t) * 512 + h * 64 + half * 32 + rl] = f2bf(ykA);
        i += 8; t = dir ? (Ls - 1 - i) : i;
        Y[(size_t)(rowbase + t) * 512 + h * 64 + half * 32 + rl] = f2bf(ykB);
      }
      if (c + 1 < nchunk) sw(buf ^ 1);
      lds_barrier();
    }
  }
}

typedef __attribute__((ext_vector_type(4))) unsigned u32x4;
__device__ __forceinline__ void hymfma_item(unsigned char* smem, CP P, int item) {
  const int tid = threadIdx.x, lane = tid & 63, w = tid >> 6;
  const int fr = lane & 15, fq = lane >> 4;
  const bool lat = item < 512;
  const int c = lat ? item : item - 512;
  const int L = lat ? 2048 : 256, nb = L >> 5, RS = L + 8;
  unsigned char* ws = P->ws;
  const u16* ST = (const u16*)(ws + L0_S) + (size_t)c * MTOT + (lat ? 0 : MLAT);
  u16* CT = (u16*)(ws + L0_HY) + (size_t)c * MTOT + (lat ? 0 : MLAT);
  const float* FT = lat ? (const float*)(ws + OFF_FILT) + (size_t)c * 4096 : (const float*)(ws + OFF_FILTC) + (size_t)c * 512;
  u16* sS = (u16*)smem;
  u16* rk0 = (u16*)(smem + 32896);
  u16* rk1 = (u16*)(smem + 32896 + 8192);
  __syncthreads();
  for (int ch = tid; ch < L; ch += NTHR) {
    const int b = ch / (L >> 3), s8 = ch % (L >> 3);
    *(uint4*)(sS + b * RS + s8 * 8) = *(const uint4*)(ST + (size_t)b * L + s8 * 8);
  }
  for (int e = tid; e < 2 * L - 1; e += NTHR) {
    const u16 v = f2bf(FT[e]);
    const int i = 2 * L - 2 - e;
    rk0[i] = v;
    if (i >= 1) rk1[i - 1] = v;
  }
  if (tid == 0) rk1[2 * L - 2] = 0;
  __syncthreads();
  const int npairs = lat ? 8 : 1;
  const int tbase = lat ? 16 * w : (4 * (w >> 1) + (w & 1));
  f32x4 acc[8][2];
#pragma unroll
  for (int p = 0; p < 8; ++p) { acc[p][0] = (f32x4){0.f, 0.f, 0.f, 0.f}; acc[p][1] = (f32x4){0.f, 0.f, 0.f, 0.f}; }
  const int cg = fr >> 3, bb = fr & 7;
  const int t1last = tbase + 4 * ((npairs - 1) >> 1) + ((npairs - 1) & 1) + 2;
  const u16* rsel = (fr & 1) ? rk0 : rk1;
  const int ioff = (L - 1) - fr + 8 * fq - ((fr & 1) ? 0 : 1);
  for (int dl = tbase - (nb - 1); dl <= t1last; ++dl) {
    const int i0 = ioff - 32 * dl;
    const unsigned* pa0 = (const unsigned*)(rsel + i0);
    const unsigned* pa1 = (const unsigned*)(rsel + i0 - 16);
    u32x4 a0v = (u32x4){pa0[0], pa0[1], pa0[2], pa0[3]};
    u32x4 a1v = (u32x4){pa1[0], pa1[1], pa1[2], pa1[3]};
    const bf16x8 A0 = __builtin_bit_cast(bf16x8, a0v), A1 = __builtin_bit_cast(bf16x8, a1v);
#pragma unroll
    for (int p = 0; p < 8; ++p) {
      if (p < npairs) {
        const int t1a = tbase + 4 * (p >> 1) + (p & 1);
        const int s1a = t1a - dl;
        if (s1a < nb && s1a + 2 >= 0) {
          const int s1 = s1a + 2 * cg;
          const bool ok = (s1 >= 0) && (s1 < nb);
          const int s1c = ok ? s1 : 0;
          u32x4 bv = *(const u32x4*)(sS + bb * RS + 32 * s1c + fq * 8);
          if (!ok) bv = (u32x4){0u, 0u, 0u, 0u};
          const bf16x8 B = __builtin_bit_cast(bf16x8, bv);
          acc[p][0] = __builtin_amdgcn_mfma_f32_16x16x32_bf16(A0, B, acc[p][0], 0, 0, 0);
          acc[p][1] = __builtin_amdgcn_mfma_f32_16x16x32_bf16(A1, B, acc[p][1], 0, 0, 0);
        }
      }
    }
  }
  const float inv = 1.f / ((const float*)(ws + OFF_SMALL + S_HNORM))[(lat ? 0 : 512) + c];
  const float skip = P->in[I_SKIP][c];
#pragma unroll
  for (int p = 0; p < 8; ++p) {
    if (p < npairs) {
      const int t1 = tbase + 4 * (p >> 1) + (p & 1) + 2 * cg;
#pragma unroll
      for (int th = 0; th < 2; ++th) {
        const int t = 32 * t1 + th * 16 + fq * 4;
        const uint2 sv = *(const uint2*)(sS + bb * RS + t);
        float o0 = acc[p][th][0] * inv + __uint_as_float(sv.x << 16) * skip;
        float o1 = acc[p][th][1] * inv + __uint_as_float(sv.x & 0xffff0000u) * skip;
        float o2 = acc[p][th][2] * inv + __uint_as_float(sv.y << 16) * skip;
        float o3 = acc[p][th][3] * inv + __uint_as_float(sv.y & 0xffff0000u) * skip;
        *(uint2*)(CT + (size_t)bb * L + t) = make_uint2(pack2(o0, o1), pack2(o2, o3));
      }
    }
  }
}

__device__ __forceinline__ void hyfinal_item(unsigned char* smem, CP P, int item) {
  const int tid = threadIdx.x;
  const int rt = item >> 3, ct = item & 7;
  const int row0 = rt * 64, c0 = ct * 64;
  const u16* CT = (const u16*)(P->ws + L0_HY);
  u16* X0 = (u16*)(P->ws + L0_X0C);
  u16* tile = (u16*)smem;
  __syncthreads();
  {
    const int i = tid >> 2, part = tid & 3;
    const u16* src = CT + (size_t)(c0 + i) * MTOT + row0 + part * 16;
    *(uint4*)(tile + i * 72 + part * 16) = *(const uint4*)src;
    *(uint4*)(tile + i * 72 + part * 16 + 8) = *(const uint4*)(src + 8);
  }
  __syncthreads();
  {
    const int r = tid >> 2, cp = tid & 3;
    u16* xp = X0 + (size_t)(row0 + r) * 512 + c0 + cp * 16;
    uint4 x0 = *(const uint4*)xp, x1 = *(const uint4*)(xp + 8);
    unsigned xin[8] = {x0.x, x0.y, x0.z, x0.w, x1.x, x1.y, x1.z, x1.w}, xo[8];
#pragma unroll
    for (int e = 0; e < 8; ++e) {
      float ya = bf2f(tile[(cp * 16 + 2 * e) * 72 + r]), yb = bf2f(tile[(cp * 16 + 2 * e + 1) * 72 + r]);
      xo[e] = pack2(__uint_as_float(xin[e] << 16) * ya, __uint_as_float(xin[e] & 0xffff0000u) * yb);
    }
    *(uint4*)xp = make_uint4(xo[0], xo[1], xo[2], xo[3]);
    *(uint4*)(xp + 8) = make_uint4(xo[4], xo[5], xo[6], xo[7]);
  }
}

__device__ __forceinline__ void rwout_phase(CP P) {
  const int lane = threadIdx.x & 63, wid = threadIdx.x >> 6;
  unsigned char* ws = P->ws;
  const u16* prw = (const u16*)(ws + L0_PRW);
  u16* Y0 = (u16*)(ws + L0_Y0); const u16* Y1 = (const u16*)(ws + L0_Y1); const u16* G = (const u16*)(ws + L0_G);
  const u16* A0 = (const u16*)((unsigned char*)P->out + DO_A0); const u16* A1 = (const u16*)((unsigned char*)P->out + DO_A1);
  const float* mu = P->in[I_MU]; const float* lnw = P->in[I_LNW]; const float* lnb = P->in[I_LNB];
  const float* rkp = P->in[I_RK]; const float* kap = P->in[I_KA];
  for (int row2 = blockIdx.x * 2; row2 < MTOT; row2 += gridDim.x * 2) {
    u16 ry0[4], ry1[4], rg[4], ra0[4], ra1[4], rv[4][3], rr[4][3], rk[4][3];
#pragma unroll
    for (int u = 0; u < 4; ++u) {
      const int row = row2 + (u >> 1), h = wid + 4 * (u & 1), col = h * 64 + lane;
      int sstart, slen; seq_of_row(row, sstart, slen);
      const int rp = (row > sstart) ? row - 1 : row, rn = (row + 1 < sstart + slen) ? row + 1 : row;
      ry0[u] = Y0[(size_t)row * 512 + col]; ry1[u] = Y1[(size_t)row * 512 + col]; rg[u] = G[(size_t)row * 512 + col];
      ra0[u] = A0[(size_t)row * 512 + col]; ra1[u] = A1[(size_t)row * 512 + col];
      const u16* p0 = prw + (size_t)rp * 1792 + col; const u16* p1 = prw + (size_t)row * 1792 + col; const u16* p2 = prw + (size_t)rn * 1792 + col;
      rr[u][0] = p0[0]; rr[u][1] = p1[0]; rr[u][2] = p2[0];
      rk[u][0] = p0[512]; rk[u][1] = p1[512]; rk[u][2] = p2[512];
      rv[u][0] = p0[1024]; rv[u][1] = p1[1024]; rv[u][2] = p2[1024];
    }
#pragma unroll
    for (int u = 0; u < 4; ++u) {
      const int row = row2 + (u >> 1), h = wid + 4 * (u & 1), col = h * 64 + lane;
      int sstart, slen; seq_of_row(row, sstart, slen);
      const bool hp = row > sstart, hn = row + 1 < sstart + slen;
      float y = bf2f(ry0[u]) + bf2f(ry1[u]);
      float mean = wave_sum(y) * (1.f / 64.f);
      float dv = y - mean;
      float var = wave_sum(dv * dv) * (1.f / 64.f);
      float yn = dv * rsqrtf(var + 64e-5f);
      float vc = bf2f(rv[u][1]), rc = bf2f(rr[u][1]), kc = bf2f(rk[u][1]);
      float vs = vc + mu[1024 + col] * (0.5f * ((hp ? bf2f(rv[u][0]) : 0.f) + (hn ? bf2f(rv[u][2]) : 0.f)) - vc);
      float rs = rc + mu[col] * (0.5f * ((hp ? bf2f(rr[u][0]) : 0.f) + (hn ? bf2f(rr[u][2]) : 0.f)) - rc);
      float ks = kc + mu[512 + col] * (0.5f * ((hp ? bf2f(rk[u][0]) : 0.f) + (hn ? bf2f(rk[u][2]) : 0.f)) - kc);
      float bq = rs * ks * rkp[col] * (2.f + (bf2f(ra0[u]) + bf2f(ra1[u]) - 2.f) * kap[col]);
      float bonus = wave_sum(bq);
      float o = (yn * lnw[col] + lnb[col] + bonus * vs) * bf2f(rg[u]);
      Y0[(size_t)row * 512 + col] = f2bf(o);
    }
  }
}

__device__ __forceinline__ void gdnprep_phase(unsigned char* smem, CP P) {
  const int tid = threadIdx.x;
  unsigned char* ws = P->ws;
  u16* pq = (u16*)(ws + L1_PQKV);
  const u16* halo = (const u16*)(ws + OFF_XCTX);
  const float* cw = P->in[I_DNCW];
  u16* raw = (u16*)smem;
  float* wl = (float*)(smem + 130 * 272);
  const int r = tid >> 1, hf = tid & 1;
  for (int it = blockIdx.x; it < 144 * 24; it += gridDim.x) {
    const int tile = it / 24, cb = it % 24, which = cb >> 3;
    const int row0 = tile * 128;
    int sstart, slen; seq_of_row(row0, sstart, slen);
    const bool hp = row0 > sstart, hn = row0 + 128 < sstart + slen;
    __syncthreads();
#pragma unroll
    for (int i = 0; i < 8; ++i) {
      int c = tid + i * 256, rr = c >> 4, kc = c & 15;
      *(uint4*)(raw + (rr + 1) * 136 + kc * 8) = *(const uint4*)(pq + (size_t)(row0 + rr) * 3072 + cb * 128 + kc * 8);
    }
    if (tid < 16) {
      uint4 v = make_uint4(0, 0, 0, 0);
      if (hp) v = *(const uint4*)(halo + (size_t)((tile - 1) * 2 + 1) * 3072 + cb * 128 + tid * 8);
      *(uint4*)(raw + tid * 8) = v;
    } else if (tid < 32) {
      uint4 v = make_uint4(0, 0, 0, 0);
      if (hn) v = *(const uint4*)(halo + (size_t)((tile + 1) * 2) * 3072 + cb * 128 + (tid - 16) * 8);
      *(uint4*)(raw + 129 * 136 + (tid - 16) * 8) = v;
    }
    for (int e = tid; e < 384; e += NTHR) wl[e] = cw[(e >> 7) * 3072 + cb * 128 + (e & 127)];
    __syncthreads();
    float o[64]; float ss = 0.f;
#pragma unroll
    for (int j = 0; j < 8; ++j) {
      const uint4 a4 = *(const uint4*)(raw + r * 136 + hf * 64 + j * 8);
      const uint4 c4 = *(const uint4*)(raw + (r + 1) * 136 + hf * 64 + j * 8);
      const uint4 n4 = *(const uint4*)(raw + (r + 2) * 136 + hf * 64 + j * 8);
      const unsigned a[4] = {a4.x, a4.y, a4.z, a4.w}, c[4] = {c4.x, c4.y, c4.z, c4.w}, n[4] = {n4.x, n4.y, n4.z, n4.w};
#pragma unroll
      for (int e = 0; e < 8; ++e) {
        const int q = e >> 1, sh = (e & 1) ? 0 : 16;
        auto ex = [&](unsigned u) { return __uint_as_float((u << sh) & 0xffff0000u); };
        const int col = hf * 64 + j * 8 + e;
        float v = siluf_(wl[col] * ex(a[q]) + wl[128 + col] * ex(c[q]) + wl[256 + col] * ex(n[q]));
        o[j * 8 + e] = v; ss += v * v;
      }
    }
    ss += __int_as_float(__builtin_amdgcn_mov_dpp(__float_as_int(ss), 0xB1, 0xF, 0xF, true));
    const float sc = (which == 0) ? rsqrtf(ss + 1e-6f) * 0.08838834764831845f : ((which == 1) ? rsqrtf(ss + 1e-6f) : 1.f);
    u16* dst = pq + (size_t)(row0 + r) * 3072 + cb * 128 + hf * 64;
#pragma unroll
    for (int j = 0; j < 8; ++j)
      *(uint4*)(dst + j * 8) = make_uint4(pack2(o[j * 8] * sc, o[j * 8 + 1] * sc), pack2(o[j * 8 + 2] * sc, o[j * 8 + 3] * sc),
                                          pack2(o[j * 8 + 4] * sc, o[j * 8 + 5] * sc), pack2(o[j * 8 + 6] * sc, o[j * 8 + 7] * sc));
  }
  __syncthreads();
  {
    const float* pab = (const float*)(ws + OFF_SMALL + S_PAB);
    float* EG = (float*)(ws + OFF_SMALL + S_EG); float* BE = (float*)(ws + OFF_SMALL + S_BETA);
    const float* alog = P->in[I_DNALOG]; const float* dtb = P->in[I_DNDT];
    for (int e = blockIdx.x * NTHR + tid; e < MTOT * 16; e += gridDim.x * NTHR) {
      const int row = e >> 4, j = e & 15;
      float av = pab[(size_t)row * 32 + j], bv = pab[(size_t)row * 32 + 16 + j];
      float g = -__expf(alog[j]) * softplusf_(av + dtb[j]);
      EG[e] = g;
      BE[e] = sigmoidf_(bv);
    }
  }
}

__device__ __forceinline__ void gdnscan_item(float* lds, CP P, int item) {
  const int tid = threadIdx.x;
  const int cgq = item & 3, dir = (item >> 2) & 1, h = (item >> 3) & 7, b = item >> 6;
  const int kq = tid & 15, cl = tid >> 4;
  unsigned char* ws = P->ws;
  const u16* pq = (const u16*)(ws + L1_PQKV);
  const float* EG = (const float*)(ws + OFF_SMALL + S_EG); const float* BE = (const float*)(ws + OFF_SMALL + S_BETA);
  u16* O = (u16*)(ws + (dir ? L1_O1 : L1_O0));
  const int SSTR = 292, BUFSZ = 16 * 292;
  __syncthreads();
  v2f s[8];
#pragma unroll
  for (int j = 0; j < 8; ++j) s[j] = (v2f){0.f, 0.f};
  const int qst = tid >> 4, qc8 = tid & 15;
  const int vst = (tid & 63) >> 2, vc8 = tid & 3;
  const int wv = tid >> 6;
  for (int seq = 0; seq < 2; ++seq) {
    const int Ls = seq ? 2048 : 256;
    const int rowbase = seq ? b * 2048 : MLAT + b * 256;
    const int nchunk = Ls / 16;
    uint4 Q1, K1, V1; float sc0 = 0.f, sc1 = 0.f;
    auto gl = [&](int c) {
      {
        int i = c * 16 + qst; int t = dir ? (Ls - 1 - i) : i; size_t row = rowbase + t;
        const u16* p = pq + row * 3072 + h * 128 + qc8 * 8;
        Q1 = *(const uint4*)p; K1 = *(const uint4*)(p + 1024);
      }
      if (wv == 0) {
        int i = c * 16 + vst; int t = dir ? (Ls - 1 - i) : i; size_t row = rowbase + t;
        V1 = *(const uint4*)(pq + row * 3072 + 2048 + h * 128 + cgq * 32 + vc8 * 8);
      } else if (wv == 1 && (tid & 63) < 16) {
        int i = c * 16 + (tid & 63); int t = dir ? (Ls - 1 - i) : i; size_t row = rowbase + t;
        sc0 = EG[row * 16 + dir * 8 + h]; sc1 = BE[row * 16 + dir * 8 + h];
      }
    };
    auto sw = [&](int buf) {
      float* bp = lds + buf * BUFSZ;
      {
        float* sp = bp + qst * SSTR + qc8 * 4;
        *(float4*)(sp) = make_float4(__uint_as_float(Q1.x << 16), __uint_as_float(Q1.x & 0xffff0000u), __uint_as_float(Q1.y << 16), __uint_as_float(Q1.y & 0xffff0000u));
        *(float4*)(sp + 64) = make_float4(__uint_as_float(Q1.z << 16), __uint_as_float(Q1.z & 0xffff0000u), __uint_as_float(Q1.w << 16), __uint_as_float(Q1.w & 0xffff0000u));
        *(float4*)(sp + 128) = make_float4(__uint_as_float(K1.x << 16), __uint_as_float(K1.x & 0xffff0000u), __uint_as_float(K1.y << 16), __uint_as_float(K1.y & 0xffff0000u));
        *(float4*)(sp + 192) = make_float4(__uint_as_float(K1.z << 16), __uint_as_float(K1.z & 0xffff0000u), __uint_as_float(K1.w << 16), __uint_as_float(K1.w & 0xffff0000u));
      }
      if (wv == 0) {
        float* sp = bp + vst * SSTR + 256 + vc8 * 8;
        *(float4*)(sp) = make_float4(__uint_as_float(V1.x << 16), __uint_as_float(V1.x & 0xffff0000u), __uint_as_float(V1.y << 16), __uint_as_float(V1.y & 0xffff0000u));
        *(float4*)(sp + 4) = make_float4(__uint_as_float(V1.z << 16), __uint_as_float(V1.z & 0xffff0000u), __uint_as_float(V1.w << 16), __uint_as_float(V1.w & 0xffff0000u));
      } else if (wv == 1 && (tid & 63) < 16) {
        bp[(tid & 63) * SSTR + 288] = sc0; bp[(tid & 63) * SSTR + 289] = sc1;
      }
    };
    gl(0);
    __syncthreads();
    sw(0);
    __syncthreads();
    for (int c = 0; c < nchunk; ++c) {
      const int buf = c & 1;
      if (c + 1 < nchunk) gl(c + 1);
      v2f okeep = (v2f){0.f, 0.f};
      float4 qpa = make_float4(0.f, 0.f, 0.f, 0.f), qpb = make_float4(0.f, 0.f, 0.f, 0.f);
      float4 qan, qbn, kan, kbn; v2f vvn; float egn, betan;
      {
        const float* sp = lds + buf * BUFSZ;
        qan = *(const float4*)(sp + kq * 4); qbn = *(const float4*)(sp + 64 + kq * 4);
        kan = *(const float4*)(sp + 128 + kq * 4); kbn = *(const float4*)(sp + 192 + kq * 4);
        vvn = *(const v2f*)(sp + 256 + cl * 2); egn = sp[288]; betan = sp[289];
      }
#pragma unroll
      for (int st = 0; st < 16; ++st) {
        const float4 qa = qan, qb = qbn, ka = kan, kb = kbn; const v2f vv = vvn; const float eg = egn, beta = betan;
        if (st < 15) {
          const float* sp = lds + buf * BUFSZ + (st + 1) * SSTR;
          qan = *(const float4*)(sp + kq * 4); qbn = *(const float4*)(sp + 64 + kq * 4);
          kan = *(const float4*)(sp + 128 + kq * 4); kbn = *(const float4*)(sp + 192 + kq * 4);
          vvn = *(const v2f*)(sp + 256 + cl * 2); egn = sp[288]; betan = sp[289];
        }
        __builtin_amdgcn_sched_barrier(0);
        v2f pk = (s[0] * ka.x + s[1] * ka.y + s[2] * ka.z + s[3] * ka.w) + (s[4] * kb.x + s[5] * kb.y + s[6] * kb.z + s[7] * kb.w);
        v2f po = (s[0] * qpa.x + s[1] * qpa.y + s[2] * qpa.z + s[3] * qpa.w) + (s[4] * qpb.x + s[5] * qpb.y + s[6] * qpb.z + s[7] * qpb.w);
        red16x2(pk, po);
        if (st > 0) { okeep.x = (kq == st - 1) ? po.x : okeep.x; okeep.y = (kq == st - 1) ? po.y : okeep.y; }
        const v2f cc = (vv - pk * eg) * beta;
        s[0] = s[0] * eg + cc * ka.x; s[1] = s[1] * eg + cc * ka.y; s[2] = s[2] * eg + cc * ka.z; s[3] = s[3] * eg + cc * ka.w;
        s[4] = s[4] * eg + cc * kb.x; s[5] = s[5] * eg + cc * kb.y; s[6] = s[6] * eg + cc * kb.z; s[7] = s[7] * eg + cc * kb.w;
        qpa = qa; qpb = qb;
        __builtin_amdgcn_sched_barrier(0);
      }
      {
        v2f po = (s[0] * qpa.x + s[1] * qpa.y + s[2] * qpa.z + s[3] * qpa.w) + (s[4] * qpb.x + s[5] * qpb.y + s[6] * qpb.z + s[7] * qpb.w);
        v2f dummy = po;
        red16x2(po, dummy);
        okeep.x = (kq == 15) ? po.x : okeep.x; okeep.y = (kq == 15) ? po.y : okeep.y;
      }
      if (seq) {
        int i = c * 16 + kq; int t = dir ? (Ls - 1 - i) : i;
        *(unsigned*)(O + (size_t)(rowbase + t) * 1024 + h * 128 + cgq * 32 + cl * 2) = pack2(okeep.x, okeep.y);
      }
      if (c + 1 < nchunk) sw(buf ^ 1);
      __syncthreads();
    }
  }
}

#define A_RL(i_, j_) __int_as_float(__builtin_amdgcn_readlane(__float_as_int(areg[((i_) * 16 + (j_)) >> 6]), ((i_) * 16 + (j_)) & 63))
__device__ __forceinline__ void gdnchunk_item(unsigned char* smem, CP P, int item) {
  const int tid = threadIdx.x, lane = tid & 63, w = tid >> 6, fr = lane & 15, fq = lane >> 4;
  const int cgq = item & 1, dir = (item >> 1) & 1, h = (item >> 2) & 7, b = item >> 5;
  unsigned char* ws = P->ws;
  const u16* pq = (const u16*)(ws + L1_PQKV);
  const float* GG = (const float*)(ws + OFF_SMALL + S_EG); const float* BE = (const float*)(ws + OFF_SMALL + S_BETA);
  u16* O = (u16*)(ws + (dir ? L1_O1 : L1_O0));
  u16* Kb = (u16*)(smem + 0);
  u16* Qb = (u16*)(smem + 4352);
  u16* Wb = (u16*)(smem + 8704);
  u16* SbT = (u16*)(smem + 13056);
  u16* KgT = (u16*)(smem + 30464);
  u16* VNT = (u16*)(smem + 40704);
  u16* RT = (u16*)(smem + 45824);
  u16* Pb = (u16*)(smem + 50944);
  u16* Tb = (u16*)(smem + 52224);
  float* Am = (float*)(smem + 53504);
  float* gsc = (float*)(smem + 54528);
  float* Vf = (float*)(smem + 54848);
  __syncthreads();
  for (int e = tid; e < 58944 / 4; e += NTHR) ((unsigned*)smem)[e] = 0u;
  f32x4 accS[4][2];
#pragma unroll
  for (int a = 0; a < 4; ++a)
#pragma unroll
    for (int c = 0; c < 2; ++c) accS[a][c] = (f32x4){0.f, 0.f, 0.f, 0.f};
  const int si = tid >> 4, sc8 = tid & 15;
  const int vi = (tid & 127) >> 3, vc8 = tid & 7;
  __syncthreads();
  for (int seq = 0; seq < 2; ++seq) {
    const int Ls = seq ? 2048 : 256;
    const int rowbase = seq ? b * 2048 : MLAT + b * 256;
    const int nchunk = Ls / 16;
    uint4 Q1, K1, V1 = make_uint4(0, 0, 0, 0); float sg = 0.f, sb = 0.f;
    auto gl = [&](int c) {
      {
        int i = c * 16 + si; int t = dir ? (Ls - 1 - i) : i; size_t row = rowbase + t;
        const u16* p = pq + row * 3072 + h * 128 + sc8 * 8;
        Q1 = *(const uint4*)p; K1 = *(const uint4*)(p + 1024);
      }
      if (w < 2) {
        int i = c * 16 + vi; int t = dir ? (Ls - 1 - i) : i; size_t row = rowbase + t;
        V1 = *(const uint4*)(pq + row * 3072 + 2048 + h * 128 + cgq * 64 + vc8 * 8);
      }
      {
        int i = c * 16 + (lane & 15); int t = dir ? (Ls - 1 - i) : i; size_t row = rowbase + t;
        sg = GG[row * 16 + dir * 8 + h]; sb = BE[row * 16 + dir * 8 + h];
      }
    };
    gl(0);
    for (int c = 0; c < nchunk; ++c) {
      *(uint4*)(Qb + si * 136 + sc8 * 8) = Q1;
      *(uint4*)(Kb + si * 136 + sc8 * 8) = K1;
      {
        float v = sg;
        v += __int_as_float(__builtin_amdgcn_update_dpp(0, __float_as_int(v), 0x111, 0xf, 0xf, false));
        v += __int_as_float(__builtin_amdgcn_update_dpp(0, __float_as_int(v), 0x112, 0xf, 0xf, false));
        v += __int_as_float(__builtin_amdgcn_update_dpp(0, __float_as_int(v), 0x114, 0xf, 0xf, false));
        v += __int_as_float(__builtin_amdgcn_update_dpp(0, __float_as_int(v), 0x118, 0xf, 0xf, false));
        const float tot = __int_as_float(__builtin_amdgcn_readlane(__float_as_int(v), 15));
        if (w == 1 && lane < 16) { gsc[lane] = sg; gsc[16 + lane] = sb; gsc[32 + lane] = v; gsc[48 + lane] = __expf(v); gsc[64 + lane] = __expf(tot - v); }
        const float gcs = __shfl(v, (lane & 48) | (si & 15)), bts = __shfl(sb, (lane & 48) | (si & 15));
        const float el = __expf(tot - gcs), bw = bts * __expf(gcs);
        const unsigned kk4[4] = {K1.x, K1.y, K1.z, K1.w};
        unsigned kw[4];
#pragma unroll
        for (int e = 0; e < 8; e += 2) {
          const float k0 = __uint_as_float(kk4[e >> 1] << 16), k1 = __uint_as_float(kk4[e >> 1] & 0xffff0000u);
          KgT[(sc8 * 8 + e) * 40 + si] = f2bf(k0 * el);
          KgT[(sc8 * 8 + e + 1) * 40 + si] = f2bf(k1 * el);
          kw[e >> 1] = pack2(k0 * bw, k1 * bw);
        }
        *(uint4*)(Wb + si * 136 + sc8 * 8) = make_uint4(kw[0], kw[1], kw[2], kw[3]);
        const float bt = __shfl(sb, (lane & 48) | vi);
        if (w < 2) {
          float* vp = Vf + vi * 64 + vc8 * 8;
          *(float4*)vp = make_float4(bt * __uint_as_float(V1.x << 16), bt * __uint_as_float(V1.x & 0xffff0000u), bt * __uint_as_float(V1.y << 16), bt * __uint_as_float(V1.y & 0xffff0000u));
          *(float4*)(vp + 4) = make_float4(bt * __uint_as_float(V1.z << 16), bt * __uint_as_float(V1.z & 0xffff0000u), bt * __uint_as_float(V1.w << 16), bt * __uint_as_float(V1.w & 0xffff0000u));
        }
      }
      __syncthreads();
      if (c + 1 < nchunk) gl(c + 1);
      f32x4 acco[2];
      acco[0] = (f32x4){0.f, 0.f, 0.f, 0.f}; acco[1] = (f32x4){0.f, 0.f, 0.f, 0.f};
      if (w < 2) {
        f32x4 a4 = (f32x4){0.f, 0.f, 0.f, 0.f};
        const u16* ab = (w == 0) ? Kb : Qb;
#pragma unroll
        for (int ks = 0; ks < 4; ++ks) {
          const bf16x8 fa = *(const bf16x8*)(ab + fr * 136 + ks * 32 + fq * 8);
          const bf16x8 fb = *(const bf16x8*)(Kb + fr * 136 + ks * 32 + fq * 8);
          a4 = __builtin_amdgcn_mfma_f32_16x16x32_bf16(fa, fb, a4, 0, 0, 0);
        }
        const float gj = gsc[32 + fr];
#pragma unroll
        for (int jj = 0; jj < 4; ++jj) {
          const int i = fq * 4 + jj;
          const float dec = __expf(fminf(gsc[32 + i] - gj, 0.f));
          if (w == 0) Am[i * 16 + fr] = (fr < i) ? gsc[16 + i] * a4[jj] * dec : 0.f;
          else Pb[i * 40 + fr] = f2bf((fr <= i) ? a4[jj] * dec : 0.f);
        }
      } else {
#pragma unroll
        for (int q = 0; q < 2; ++q) {
          const int nt = (w - 2) + 2 * q;
          f32x4 ks4 = (f32x4){0.f, 0.f, 0.f, 0.f};
#pragma unroll
          for (int ks = 0; ks < 4; ++ks) {
            const bf16x8 fb = *(const bf16x8*)(SbT + (nt * 16 + fr) * 136 + ks * 32 + fq * 8);
            const bf16x8 fa = *(const bf16x8*)(Qb + fr * 136 + ks * 32 + fq * 8);
            const bf16x8 fw = *(const bf16x8*)(Wb + fr * 136 + ks * 32 + fq * 8);
            acco[q] = __builtin_amdgcn_mfma_f32_16x16x32_bf16(fa, fb, acco[q], 0, 0, 0);
            ks4 = __builtin_amdgcn_mfma_f32_16x16x32_bf16(fw, fb, ks4, 0, 0, 0);
          }
          float rr[4];
#pragma unroll
          for (int jj = 0; jj < 4; ++jj) rr[jj] = Vf[(fq * 4 + jj) * 64 + nt * 16 + fr] - ks4[jj];
          *(uint2*)(RT + (nt * 16 + fr) * 40 + fq * 4) = make_uint2(pack2(rr[0], rr[1]), pack2(rr[2], rr[3]));
        }
      }
      __syncthreads();
      if (w == 0) {
        float areg[4];
#pragma unroll
        for (int q = 0; q < 4; ++q) areg[q] = Am[q * 64 + lane];
        float x[16];
#pragma unroll
        for (int i = 0; i < 16; ++i) x[i] = (i == fr) ? 1.f : 0.f;
#pragma unroll
        for (int j2 = 0; j2 < 15; ++j2)
#pragma unroll
          for (int i = j2 + 1; i < 16; ++i) x[i] -= A_RL(i, j2) * x[j2];
        if (lane < 16) {
#pragma unroll
          for (int i = 0; i < 16; ++i) Tb[i * 40 + lane] = f2bf(x[i]);
        }
      }
      __syncthreads();
      if (w >= 2) {
        const bf16x8 ft = *(const bf16x8*)(Tb + fr * 40 + fq * 8);
#pragma unroll
        for (int q = 0; q < 2; ++q) {
          const int nt = (w - 2) + 2 * q;
          const bf16x8 fb = *(const bf16x8*)(RT + (nt * 16 + fr) * 40 + fq * 8);
          const f32x4 vn = __builtin_amdgcn_mfma_f32_16x16x32_bf16(ft, fb, (f32x4){0.f, 0.f, 0.f, 0.f}, 0, 0, 0);
          *(uint2*)(VNT + (nt * 16 + fr) * 40 + fq * 4) = make_uint2(pack2(vn[0], vn[1]), pack2(vn[2], vn[3]));
        }
      }
      __syncthreads();
      if (w >= 2) {
        const bf16x8 fa = *(const bf16x8*)(Pb + fr * 40 + fq * 8);
#pragma unroll
        for (int q = 0; q < 2; ++q) {
          const int nt = (w - 2) + 2 * q;
          f32x4 ao = acco[q];
#pragma unroll
          for (int jj = 0; jj < 4; ++jj) ao[jj] *= gsc[48 + fq * 4 + jj];
          const bf16x8 fb = *(const bf16x8*)(VNT + (nt * 16 + fr) * 40 + fq * 8);
          ao = __builtin_amdgcn_mfma_f32_16x16x32_bf16(fa, fb, ao, 0, 0, 0);
          if (seq) {
#pragma unroll
            for (int jj = 0; jj < 4; ++jj) {
              const int i = c * 16 + fq * 4 + jj; const int t = dir ? (Ls - 1 - i) : i;
              O[(size_t)(rowbase + t) * 1024 + h * 128 + cgq * 64 + nt * 16 + fr] = f2bf(ao[jj]);
            }
          }
        }
      }
      {
        const float egl = gsc[48 + 15];
        const bf16x8 fb0 = *(const bf16x8*)(KgT + ((2 * w) * 16 + fr) * 40 + fq * 8);
        const bf16x8 fb1 = *(const bf16x8*)(KgT + ((2 * w + 1) * 16 + fr) * 40 + fq * 8);
#pragma unroll
        for (int vt = 0; vt < 4; ++vt) {
          const bf16x8 fa = *(const bf16x8*)(VNT + (vt * 16 + fr) * 40 + fq * 8);
          f32x4 a0 = accS[vt][0], a1 = accS[vt][1];
#pragma unroll
          for (int jj = 0; jj < 4; ++jj) { a0[jj] *= egl; a1[jj] *= egl; }
          a0 = __builtin_amdgcn_mfma_f32_16x16x32_bf16(fa, fb0, a0, 0, 0, 0);
          a1 = __builtin_amdgcn_mfma_f32_16x16x32_bf16(fa, fb1, a1, 0, 0, 0);
          accS[vt][0] = a0; accS[vt][1] = a1;
#pragma unroll
          for (int jj = 0; jj < 4; ++jj) {
            SbT[(vt * 16 + fq * 4 + jj) * 136 + (2 * w) * 16 + fr] = f2bf(a0[jj]);
            SbT[(vt * 16 + fq * 4 + jj) * 136 + (2 * w + 1) * 16 + fr] = f2bf(a1[jj]);
          }
        }
      }
      __syncthreads();
    }
  }
}

__device__ __forceinline__ void gdngate_phase(CP P) {
  const int lane = threadIdx.x & 63, wid = threadIdx.x >> 6;
  unsigned char* ws = P->ws;
  u16* O0 = (u16*)(ws + L1_O0); const u16* O1 = (const u16*)(ws + L1_O1); const u16* PZ = (const u16*)(ws + L1_PZ);
  const float nw0 = P->in[I_DNNORM][lane * 2], nw1 = P->in[I_DNNORM][lane * 2 + 1];
  for (int row2 = blockIdx.x * 2; row2 < MLAT; row2 += gridDim.x * 2) {
    unsigned ra[4], rb[4], rz[4];
#pragma unroll
    for (int u = 0; u < 4; ++u) {
      const size_t idx = (size_t)(row2 + (u >> 1)) * 1024 + (wid + 4 * (u & 1)) * 128 + lane * 2;
      ra[u] = *(const unsigned*)(O0 + idx); rb[u] = *(const unsigned*)(O1 + idx); rz[u] = *(const unsigned*)(PZ + idx);
    }
#pragma unroll
    for (int u = 0; u < 4; ++u) {
      const size_t idx = (size_t)(row2 + (u >> 1)) * 1024 + (wid + 4 * (u & 1)) * 128 + lane * 2;
      float o1 = __uint_as_float(ra[u] << 16) + __uint_as_float(rb[u] << 16);
      float o2 = __uint_as_float(ra[u] & 0xffff0000u) + __uint_as_float(rb[u] & 0xffff0000u);
      float ss = wave_sum(o1 * o1 + o2 * o2);
      float rs = rsqrtf(ss * (1.f / 128.f) + 1e-6f);
      float z1 = __uint_as_float(rz[u] << 16), z2 = __uint_as_float(rz[u] & 0xffff0000u);
      *(unsigned*)(O0 + idx) = pack2(o1 * rs * nw0 * siluf_(z1), o2 * rs * nw1 * siluf_(z2));
    }
  }
}

__device__ __forceinline__ void final_norm_phase(CP P) {
  const int lane = threadIdx.x & 63, wid = threadIdx.x >> 6;
  const float* nw = P->in[I_FNORM];
  for (int row = blockIdx.x * 4 + wid; row < MLAT; row += gridDim.x * 4) {
    float* src = P->out + (size_t)row * 1024;
    float4 v[4]; float ss = 0.f;
#pragma unroll
    for (int i = 0; i < 4; ++i) { v[i] = *(const float4*)(src + (i * 64 + lane) * 4); ss += v[i].x * v[i].x + v[i].y * v[i].y + v[i].z * v[i].z + v[i].w * v[i].w; }
    ss = wave_sum(ss);
    const float rs = rsqrtf(ss * (1.f / 1024.f) + 1e-6f);
#pragma unroll
    for (int i = 0; i < 4; ++i) {
      int c = (i * 64 + lane) * 4;
      float4 w = *(const float4*)(nw + c);
      *(float4*)(src + c) = make_float4(v[i].x * rs * w.x, v[i].y * rs * w.y, v[i].z * rs * w.z, v[i].w * rs * w.w);
    }
  }
}

#ifndef PMASK
#define PMASK 0xFFFFFFFFu
#endif
#define PM(k) if (PMASK & (1u << (k))) if (CP P = launder(P0))
__global__ void __launch_bounds__(NTHR, 2) fwd_megakernel(Params Parg) {
  extern __shared__ __attribute__((aligned(16))) unsigned char smem[];
  cg::grid_group grid = cg::this_grid();
  float* ldsf = (float*)smem;
  CP P0 = (CP)__builtin_amdgcn_kernarg_segment_ptr();
  unsigned char* ws = P0->ws;
  const int G = gridDim.x, bx = blockIdx.x;
  float* modv = (float*)(ws + OFF_SMALL + S_MODV);
  float* xctx = (float*)(ws + OFF_XCTX);
  volatile LAS unsigned* xst = (volatile LAS unsigned*)((LAS unsigned char*)smem + (LDS_BYTES - 32));
  if (threadIdx.x < 2) xst[threadIdx.x] = 0u;
  __syncthreads();
  XcdBarrier xbar = xcd_barrier_post((unsigned*)(ws + OFF_SMALL + S_BAR), xst);

  PM(0) {
    if (bx == 0) { float* hn = (float*)(ws + OFF_SMALL + S_HNORM); for (int e = threadIdx.x; e < 1024; e += NTHR) hn[e] = 0.f;
      if (threadIdx.x == 0) *(int*)(ws + OFF_SMALL + S_PAB) = 0; }
    for (int it = bx; it < 384; it += G) modv_item(ldsf, P, it);
    for (int it = bx; it < 576; it += G) h3_item(ldsf, P, it);
    wconv_layer(ldsf, P, 0, G - 1 - bx, G);
  }
  if (gridDim.x == 0x7fffffffu) grid.sync();
  xcd_barrier(xbar);
  PM(1) {
    for (int it = bx; it < 288; it += G) kun_item(ldsf, P, it);
    norm_phase(P->in[I_X], P->in[I_CTX], MTOT, P->in[I_NMIX], modv, 0, 1, (u16*)(ws + L0_H));
  }
  xcd_barrier(xbar);
  PM(2) {
    ASrc a{(const u16*)(ws + L0_H), 1024, (const u16*)(ws + L0_H), 1024, 1 << 30};
    gemm_phase(smem, a, (const u16*)(ws + W_IN), MTOT, 3328, 1024, EpiInProj0{(u16*)(ws + L0_PRW), (u16*)(ws + L0_PHY)});
  }
  xcd_barrier(xbar);
  PM(3) {
    for (int it = bx; it < 1152 * 2; it += G) { if (it < 1152) lrprep_item(P, it); else hyprep_item(P, it - 1152); }
  }
  xcd_barrier(xbar);
  PM(3) {
    u16* A0p = (u16*)((unsigned char*)P->out + DO_A0); u16* A1p = (u16*)((unsigned char*)P->out + DO_A1);
    u16* OM0p = (u16*)((unsigned char*)P->out + DO_OM0); u16* OM1p = (u16*)(ws + L0_OM1);
    const u16* LRp = (const u16*)(ws + L0_LR);
    { ASrc a{LRp, 256, LRp, 256, 1 << 30};
      gemm_phase(smem, a, (const u16*)(ws + W_LRW), MTOT, 1024, 64, EpiLrW{OM0p, OM1p, P->in[I_RW0]}); }
    { ASrc a{LRp + 64, 256, LRp + 64, 256, 1 << 30};
      gemm_phase(smem, a, (const u16*)(ws + W_LRA), MTOT, 1024, 64, EpiLrA{A0p, A1p, P->in[I_A0]}); }
    { ASrc a{LRp + 128, 256, LRp + 128, 256, 1 << 30};
      gemm_phase(smem, a, (const u16*)(ws + W_LRG), MTOT, 512, 128, EpiLrG{(u16*)(ws + L0_G)}); }
  }
  xcd_barrier(xbar);
  PM(4) {
    if (bx < (G >> 1)) for (int it = bx; it < 256; it += (G >> 1)) rwscan_item(ldsf, P, it);
    int* qctr = (int*)(ws + OFF_SMALL + S_PAB);
    int* qsh = (int*)(smem + LDS_BYTES - 16);
    for (;;) {
      __syncthreads();
      if (threadIdx.x == 0) *qsh = atomicAdd(qctr, 1);
      __syncthreads();
      const int it = *qsh;
      if (it >= 1024) break;
      hymfma_item(smem, P, it);
    }
  }
  xcd_barrier(xbar);
  PM(5) { rwout_phase(P); for (int it = bx; it < 288 * 8; it += G) hyfinal_item(smem, P, it); }
  xcd_barrier(xbar);
  PM(6) {
    ASrc a{(const u16*)(ws + L0_Y0), 512, (const u16*)(ws + L0_X0C), 512, 512};
    gemm_phase(smem, a, (const u16*)(ws + W_OUT), MTOT, 1024, 1024, EpiResid{P->in[I_X], P->in[I_CTX], P->out, xctx, modv + 2 * 1024});
  }
  xcd_barrier(xbar);
  PM(7) norm_phase(P->out, xctx, MTOT, P->in[I_NMLP], modv, 3, 4, (u16*)(ws + L0_H));
  xcd_barrier(xbar);
  PM(8) {
    ASrc a{(const u16*)(ws + L0_H), 1024, (const u16*)(ws + L0_H), 1024, 1 << 30};
    gemm_phase(smem, a, (const u16*)(ws + W_1), MTOT, 4096, 1024, EpiRelu2{(u16*)(ws + L0_U)});
  }
  xcd_barrier(xbar);
  PM(9) {
    ASrc a{(const u16*)(ws + L0_U), 4096, (const u16*)(ws + L0_U), 4096, 1 << 30};
    gemm_phase(smem, a, (const u16*)(ws + W_2), MTOT, 1024, 4096, EpiResid{P->out, xctx, P->out, xctx, modv + 5 * 1024});
  }
  xcd_barrier(xbar);
  const float* modv1 = modv + 9 * 6144;
  PM(10) {
    norm_phase(P->out, xctx, MTOT, P->in[I_NMIX] + 1024, modv1, 0, 1, (u16*)(ws + L1_H));
    wconv_layer(ldsf, P, 1, bx, G);
  }
  xcd_barrier(xbar);
  PM(11) {
    ASrc a{(const u16*)(ws + L1_H), 1024, (const u16*)(ws + L1_H), 1024, 1 << 30};
    gemm_phase(smem, a, (const u16*)(ws + W_IN), MTOT, 4224, 1024,
               EpiInProj1{(u16*)(ws + L1_PQKV), (u16*)(ws + L1_PZ), (float*)(ws + OFF_SMALL + S_PAB), (u16*)(ws + OFF_XCTX)});
  }
  xcd_barrier(xbar);
  PM(12) gdnprep_phase(smem, P);
  xcd_barrier(xbar);
  PM(13) { if (bx < (G >> 1)) for (int it = bx; it < 256; it += (G >> 1)) gdnchunk_item(smem, P, it); }
  xcd_barrier(xbar);
  PM(14) gdngate_phase(P);
  xcd_barrier(xbar);
  PM(15) {
    ASrc a{(const u16*)(ws + L1_O0), 1024, (const u16*)(ws + L1_O0), 1024, 1 << 30};
    gemm_phase(smem, a, (const u16*)(ws + W_OUT), MLAT, 1024, 1024, EpiResid{P->out, xctx, P->out, xctx, modv1 + 2 * 1024});
  }
  xcd_barrier(xbar);
  PM(16) norm_phase(P->out, xctx, MLAT, P->in[I_NMLP] + 1024, modv1, 3, 4, (u16*)(ws + L1_H));
  xcd_barrier(xbar);
  PM(17) {
    ASrc a{(const u16*)(ws + L1_H), 1024, (const u16*)(ws + L1_H), 1024, 1 << 30};
    gemm_phase(smem, a, (const u16*)(ws + W_1), MLAT, 4096, 1024, EpiRelu2{(u16*)(ws + L1_U)});
  }
  xcd_barrier(xbar);
  PM(18) {
    ASrc a{(const u16*)(ws + L1_U), 4096, (const u16*)(ws + L1_U), 4096, 1 << 30};
    gemm_phase(smem, a, (const u16*)(ws + W_2), MLAT, 1024, 4096, EpiResid{P->out, xctx, P->out, xctx, modv1 + 5 * 1024});
  }
  xcd_barrier(xbar);
  PM(19) final_norm_phase(P);
}

extern "C" void kernel_launch(void* const* d_in, const int* in_sizes, int n_in, void* d_out, int out_size, void* d_ws, size_t ws_size,
                              hipStream_t stream) {
  static int grid_blocks = 0;
  if (!grid_blocks) {
    int dev = 0, cus = 0, per_cu = 0;
    hipGetDevice(&dev);
    hipDeviceGetAttribute(&cus, hipDeviceAttributeMultiprocessorCount, dev);
    hipFuncSetAttribute((const void*)fwd_megakernel, hipFuncAttributeMaxDynamicSharedMemorySize, LDS_BYTES);
    hipOccupancyMaxActiveBlocksPerMultiprocessor(&per_cu, (const void*)fwd_megakernel, NTHR, LDS_BYTES);
    if (per_cu < 1) per_cu = 1;
    if (per_cu > 2) per_cu = 2;
    grid_blocks = cus * per_cu;
    if (ws_size < WS_NEED) fprintf(stderr, "kernel_launch: workspace too small: %zu < %zu\n", ws_size, (size_t)WS_NEED);
  }
  Params p{};
  for (int i = 0; i < 41; ++i) p.in[i] = (const float*)d_in[i];
  p.out = (float*)d_out;
  p.ws = (unsigned char*)d_ws;
  (void)hipMemsetAsync((unsigned char*)d_ws + OFF_SMALL + S_BAR, 0, XCD_BAR_WORDS * 4, stream);
  void* args[] = {&p};
  hipError_t e = hipLaunchCooperativeKernel((const void*)fwd_megakernel, dim3(grid_blocks), dim3(NTHR), args, LDS_BYTES, stream);
  if (e != hipSuccess) fprintf(stderr, "cooperative launch failed: %s (grid %d)\n", hipGetErrorString(e), grid_blocks);
}
```

```cpp
#include <hip/hip_runtime.h>
#include <hip/hip_cooperative_groups.h>
#include <stdint.h>
#include <stdio.h>
namespace cg = cooperative_groups;

typedef unsigned short u16;
typedef __attribute__((ext_vector_type(8))) short bf16x8;
typedef __attribute__((ext_vector_type(4))) float f32x4;

#define NTHR 256
#define MLAT 16384
#define MCTX 2048
#define MTOT 18432
#define LDS_BYTES 73728

constexpr size_t W_IN = 0, W_OUT = 8650752, W_1 = 10747904, W_2 = 19136512, SZ_W = 27525120;
constexpr size_t OFF_SMALL = SZ_W;
constexpr size_t S_MODV = 0;
constexpr size_t S_RNORM = 458752;
constexpr size_t S_BONUS = S_RNORM + 589824;
constexpr size_t S_H3 = S_BONUS + 589824;
constexpr size_t S_HNORM = S_H3 + 589824;
constexpr size_t S_EG = S_HNORM + 4096;
constexpr size_t S_BETA = S_EG + 1179648;
constexpr size_t S_PAB = S_BETA + 1179648;
constexpr size_t S_BAR = 6951936;
constexpr size_t SZ_SMALL = 8388608;
static_assert(S_PAB + 2359296 <= SZ_SMALL, "small");
constexpr size_t OFF_XCTX = OFF_SMALL + SZ_SMALL;
constexpr size_t OFF_A1 = OFF_XCTX + 8388608;
constexpr size_t OFF_FILT = OFF_A1;
constexpr size_t OFF_FILTC = OFF_FILT + 8388608;
constexpr size_t OFF_A0 = OFF_FILT + 9437184;
constexpr size_t SZ_T512 = (size_t)MTOT * 512 * 2;
constexpr size_t L0_H = OFF_A0;
constexpr size_t L0_PRW = L0_H + (size_t)MTOT * 1024 * 2;
constexpr size_t L0_PHY = L0_PRW + (size_t)MTOT * 1792 * 2;
constexpr size_t L0_S = L0_PHY + (size_t)MTOT * 1536 * 2;
constexpr size_t L0_X0C = L0_S + SZ_T512;
constexpr size_t L0_OM1 = L0_H, L0_G = L0_H + SZ_T512;
constexpr size_t L0_LR = L0_X0C + SZ_T512;
static_assert(L0_LR + (size_t)MTOT * 256 * 2 <= 268435456, "ws");
constexpr size_t W_LRW = W_IN + 6815744, W_LRA = W_LRW + 131072, W_LRG = W_LRA + 131072;
constexpr size_t L0_Y0 = L0_PHY, L0_Y1 = L0_PHY + SZ_T512, L0_HY = L0_PHY + 2 * SZ_T512;
constexpr size_t L0_U = L0_PRW;
static_assert(L0_X0C + SZ_T512 <= 268435456, "ws");
static_assert(L0_U + (size_t)MTOT * 4096 * 2 <= 268435456, "ws");
constexpr size_t DO_A0 = 0, DO_A1 = SZ_T512, DO_OM0 = 2 * SZ_T512;
constexpr size_t L1_H = OFF_A1;
constexpr size_t L1_PQKV = L1_H + (size_t)MTOT * 1024 * 2;
constexpr size_t L1_PZ = L1_PQKV + (size_t)MTOT * 3072 * 2;
constexpr size_t L1_O1 = L1_PZ + (size_t)MTOT * 1024 * 2;
constexpr size_t L1_O0 = L1_H;
constexpr size_t L1_U = L1_PQKV;
static_assert(L1_O1 + (size_t)MLAT * 1024 * 2 <= 268435456, "ws");
constexpr size_t WS_NEED = 268435456;

struct Params { const float* in[41]; float* out; unsigned char* ws; };
typedef const __attribute__((address_space(4))) Params* CP;
__device__ __forceinline__ CP launder(CP p) { asm volatile("" : "+s"(p)); return p; }

enum { I_X = 0, I_C, I_CTX, I_CCTX, I_ADAW, I_ADAB, I_NMIX, I_NMLP, I_W1, I_W2, I_FNORM, I_ABIN, I_ABOUT, I_MU, I_RW0, I_WUP,
       I_A0, I_AUP, I_GUP, I_KK, I_KA, I_RK, I_LNW, I_LNB, I_HCW, I_HCB, I_FW1, I_FB1, I_FW2, I_FB2, I_FW3, I_FB3, I_FW4,
       I_FREQ, I_SKIP, I_DNIN, I_DNCW, I_DNALOG, I_DNDT, I_DNNORM, I_DNOUT };

__device__ __forceinline__ u16 f2bf(float f) { unsigned u = __float_as_uint(f); u += 0x7fffu + ((u >> 16) & 1u); return (u16)(u >> 16); }
__device__ __forceinline__ float bf2f(u16 h) { return __uint_as_float(((unsigned)h) << 16); }
__device__ __forceinline__ unsigned pack2(float a, float b) { return (unsigned)f2bf(a) | ((unsigned)f2bf(b) << 16); }
__device__ __forceinline__ float sigmoidf_(float x) { return 1.f / (1.f + __expf(-x)); }
__device__ __forceinline__ float siluf_(float x) { return x / (1.f + __expf(-x)); }
__device__ __forceinline__ float softplusf_(float x) { return fmaxf(x, 0.f) + log1pf(__expf(-fabsf(x))); }
__device__ __forceinline__ float wave_sum(float v) {
  v += __int_as_float(__builtin_amdgcn_mov_dpp(__float_as_int(v), 0xB1, 0xF, 0xF, true));
  v += __int_as_float(__builtin_amdgcn_mov_dpp(__float_as_int(v), 0x4E, 0xF, 0xF, true));
  v += __int_as_float(__builtin_amdgcn_mov_dpp(__float_as_int(v), 0x141, 0xF, 0xF, true));
  v += __int_as_float(__builtin_amdgcn_mov_dpp(__float_as_int(v), 0x140, 0xF, 0xF, true));
  float a = __int_as_float(__builtin_amdgcn_readlane(__float_as_int(v), 0)), b = __int_as_float(__builtin_amdgcn_readlane(__float_as_int(v), 16));
  float c = __int_as_float(__builtin_amdgcn_readlane(__float_as_int(v), 32)), d = __int_as_float(__builtin_amdgcn_readlane(__float_as_int(v), 48));
  return (a + b) + (c + d);
}
typedef float v2f __attribute__((ext_vector_type(2)));
__device__ __forceinline__ float red8(float v) {
  v += __int_as_float(__builtin_amdgcn_mov_dpp(__float_as_int(v), 0xB1, 0xF, 0xF, true));
  v += __int_as_float(__builtin_amdgcn_mov_dpp(__float_as_int(v), 0x4E, 0xF, 0xF, true));
  v += __int_as_float(__builtin_amdgcn_mov_dpp(__float_as_int(v), 0x141, 0xF, 0xF, true));
  return v;
}
__device__ __forceinline__ float red16(float v) {
  v = red8(v);
  v += __int_as_float(__builtin_amdgcn_mov_dpp(__float_as_int(v), 0x140, 0xF, 0xF, true));
  return v;
}

#define RED16S(v) do { v += DPPF(v, 0xB1); v += DPPF(v, 0x4E); v += DPPF(v, 0x141); v += DPPF(v, 0x140); } while (0)
#define DPPF(v, ctrl) __int_as_float(__builtin_amdgcn_mov_dpp(__float_as_int(v), ctrl, 0xF, 0xF, true))
__device__ __forceinline__ void red16x2(v2f& a, v2f& b) {
  { v2f ta, tb; ta.x = DPPF(a.x, 0xB1); ta.y = DPPF(a.y, 0xB1); tb.x = DPPF(b.x, 0xB1); tb.y = DPPF(b.y, 0xB1); a += ta; b += tb; }
  { v2f ta, tb; ta.x = DPPF(a.x, 0x4E); ta.y = DPPF(a.y, 0x4E); tb.x = DPPF(b.x, 0x4E); tb.y = DPPF(b.y, 0x4E); a += ta; b += tb; }
  { v2f ta, tb; ta.x = DPPF(a.x, 0x141); ta.y = DPPF(a.y, 0x141); tb.x = DPPF(b.x, 0x141); tb.y = DPPF(b.y, 0x141); a += ta; b += tb; }
  { v2f ta, tb; ta.x = DPPF(a.x, 0x140); ta.y = DPPF(a.y, 0x140); tb.x = DPPF(b.x, 0x140); tb.y = DPPF(b.y, 0x140); a += ta; b += tb; }
}

#define XB_TMO      128
#define XB_XCNT(j)  (256  + 64 * (j))
#define XB_XSUB(j)  (1280 + 64 * (j))
#define XB_XGEN(j)  (2304 + 64 * (j))
#define XB_TOP      3328
#define XB_TOPGEN   3392
#define XCD_BAR_WORDS 3456
#define XB_SPIN_CAP (1u << 18)
#define LAS __attribute__((address_space(3)))

__device__ __forceinline__ unsigned xb_ld(unsigned* p)              { return __hip_atomic_load(p, __ATOMIC_RELAXED, __HIP_MEMORY_SCOPE_AGENT); }
__device__ __forceinline__ unsigned xb_add(unsigned* p, unsigned v) { return __hip_atomic_fetch_add(p, v, __ATOMIC_RELAXED, __HIP_MEMORY_SCOPE_AGENT); }
__device__ __forceinline__ unsigned xb_xcc_id() { return (unsigned)__builtin_amdgcn_s_getreg((3 << 11) | 20) & 0xFu; }
#define XB_SPIN(cond, bar) do { unsigned _sp = 0; while (cond) { __builtin_amdgcn_s_sleep(1); \
    if ((++_sp & 255u) == 0u) { if (xb_ld(&(bar)[XB_TMO])) break; if (_sp > XB_SPIN_CAP) { atomicAdd(&(bar)[XB_TMO], 1u); break; } } } } while (0)

struct XcdBarrier {
    unsigned* bar; unsigned x;
    volatile LAS unsigned* st;
};

__device__ __forceinline__ XcdBarrier xcd_barrier_post(unsigned* bar, volatile LAS unsigned* st) {
    XcdBarrier b; b.bar = bar; b.x = xb_xcc_id(); b.st = st;
    if (threadIdx.x == 0) (void)xb_add(&bar[XB_XCNT(b.x)], 1u);
    return b;
}
__device__ __forceinline__ void xcd_barrier_complete(unsigned* bar, unsigned x, unsigned& nloc, unsigned& nx) {
    const unsigned G = gridDim.x * gridDim.y * gridDim.z;
    unsigned sum, cnt, mine, sp = 0u;
    for (;;) {
        sum = 0u; cnt = 0u; mine = 0u;
#pragma unroll
        for (unsigned j = 0; j < 16; ++j) { const unsigned c = xb_ld(&bar[XB_XCNT(j)]); sum += c; cnt += (c > 0u) ? 1u : 0u; mine = (j == x) ? c : mine; }
        if (sum == G) break;
        __builtin_amdgcn_s_sleep(1);
        if ((++sp & 255u) == 0u) { if (xb_ld(&bar[XB_TMO])) break; if (sp > XB_SPIN_CAP) { atomicAdd(&bar[XB_TMO], 1u); break; } }
    }
    nloc = mine > 0u ? mine : 1u; nx = cnt > 0u ? cnt : 1u;
}

__device__ __forceinline__ void xcd_barrier(const XcdBarrier& b) {
    asm volatile("s_waitcnt vmcnt(0)" ::: "memory");
    __syncthreads();
    if (threadIdx.x == 0) {
        unsigned* bar = b.bar;
        __builtin_amdgcn_s_waitcnt(0);
        unsigned nloc = b.st[0], nx = b.st[1];
        if (nloc == 0u) { xcd_barrier_complete(bar, b.x, nloc, nx); b.st[0] = nloc; b.st[1] = nx; }
        const unsigned old = xb_add(&bar[XB_XSUB(b.x)], 1u);
        const unsigned gen = old / nloc;
        if (old + 1u == (gen + 1u) * nloc) {
            __builtin_amdgcn_fence(__ATOMIC_RELEASE, "agent");
            asm volatile("s_waitcnt vmcnt(0)" ::: "memory");
            const unsigned og = xb_add(&bar[XB_TOP], 1u);
            const unsigned tg = og / nx;
            if (og + 1u == (tg + 1u) * nx) xb_add(&bar[XB_TOPGEN], 1u);
            else XB_SPIN(xb_ld(&bar[XB_TOPGEN]) == tg, bar);
            __builtin_amdgcn_fence(__ATOMIC_ACQUIRE, "agent");
            xb_add(&bar[XB_XGEN(b.x)], 1u);
            asm volatile("s_waitcnt vmcnt(0)" ::: "memory");
        } else {
            XB_SPIN(xb_ld(&bar[XB_XGEN(b.x)]) == gen, bar);
            __builtin_amdgcn_fence(__ATOMIC_ACQUIRE, "agent");
            asm volatile("s_waitcnt vmcnt(0)" ::: "memory");
        }
    }
    __syncthreads();
}


__device__ __forceinline__ float fma_s(float a, float b, float c) { float d; asm("v_fma_f32 %0, %1, %2, %3" : "=v"(d) : "v"(a), "v"(b), "v"(c)); return d; }
__device__ __forceinline__ float mul_s(float a, float b) { float d; asm("v_mul_f32 %0, %1, %2" : "=v"(d) : "v"(a), "v"(b)); return d; }
__device__ __forceinline__ void red16q(float& a, float& b, float& c, float& d) {
  asm("s_nop 1\n\t"
      "v_add_f32_dpp %0, %0, %0 quad_perm:[1,0,3,2] row_mask:0xf bank_mask:0xf bound_ctrl:1\n\t"
      "v_add_f32_dpp %1, %1, %1 quad_perm:[1,0,3,2] row_mask:0xf bank_mask:0xf bound_ctrl:1\n\t"
      "v_add_f32_dpp %2, %2, %2 quad_perm:[1,0,3,2] row_mask:0xf bank_mask:0xf bound_ctrl:1\n\t"
      "v_add_f32_dpp %3, %3, %3 quad_perm:[1,0,3,2] row_mask:0xf bank_mask:0xf bound_ctrl:1\n\t"
      "v_add_f32_dpp %0, %0, %0 quad_perm:[2,3,0,1] row_mask:0xf bank_mask:0xf bound_ctrl:1\n\t"
      "v_add_f32_dpp %1, %1, %1 quad_perm:[2,3,0,1] row_mask:0xf bank_mask:0xf bound_ctrl:1\n\t"
      "v_add_f32_dpp %2, %2, %2 quad_perm:[2,3,0,1] row_mask:0xf bank_mask:0xf bound_ctrl:1\n\t"
      "v_add_f32_dpp %3, %3, %3 quad_perm:[2,3,0,1] row_mask:0xf bank_mask:0xf bound_ctrl:1\n\t"
      "v_add_f32_dpp %0, %0, %0 row_half_mirror row_mask:0xf bank_mask:0xf bound_ctrl:1\n\t"
      "v_add_f32_dpp %1, %1, %1 row_half_mirror row_mask:0xf bank_mask:0xf bound_ctrl:1\n\t"
      "v_add_f32_dpp %2, %2, %2 row_half_mirror row_mask:0xf bank_mask:0xf bound_ctrl:1\n\t"
      "v_add_f32_dpp %3, %3, %3 row_half_mirror row_mask:0xf bank_mask:0xf bound_ctrl:1\n\t"
      "v_add_f32_dpp %0, %0, %0 row_mirror row_mask:0xf bank_mask:0xf bound_ctrl:1\n\t"
      "v_add_f32_dpp %1, %1, %1 row_mirror row_mask:0xf bank_mask:0xf bound_ctrl:1\n\t"
      "v_add_f32_dpp %2, %2, %2 row_mirror row_mask:0xf bank_mask:0xf bound_ctrl:1\n\t"
      "v_add_f32_dpp %3, %3, %3 row_mirror row_mask:0xf bank_mask:0xf bound_ctrl:1\n\t"
      "s_nop 1"
      : "+v"(a), "+v"(b), "+v"(c), "+v"(d));
}

__device__ __forceinline__ void red8d(float& a, float& b) {
  asm("s_nop 1\n\t"
      "v_add_f32_dpp %0, %0, %0 quad_perm:[1,0,3,2] row_mask:0xf bank_mask:0xf bound_ctrl:1\n\t"
      "v_add_f32_dpp %1, %1, %1 quad_perm:[1,0,3,2] row_mask:0xf bank_mask:0xf bound_ctrl:1\n\t"
      "s_nop 0\n\t"
      "v_add_f32_dpp %0, %0, %0 quad_perm:[2,3,0,1] row_mask:0xf bank_mask:0xf bound_ctrl:1\n\t"
      "v_add_f32_dpp %1, %1, %1 quad_perm:[2,3,0,1] row_mask:0xf bank_mask:0xf bound_ctrl:1\n\t"
      "s_nop 0\n\t"
      "v_add_f32_dpp %0, %0, %0 row_half_mirror row_mask:0xf bank_mask:0xf bound_ctrl:1\n\t"
      "v_add_f32_dpp %1, %1, %1 row_half_mirror row_mask:0xf bank_mask:0xf bound_ctrl:1\n\t"
      "s_nop 0"
      : "+v"(a), "+v"(b));
}

__device__ __forceinline__ void lds_barrier() {
  asm volatile("s_waitcnt lgkmcnt(0)" ::: "memory");
  __builtin_amdgcn_s_barrier();
  asm volatile("" ::: "memory");
}

#define LDSROW 64
struct ASrc { const u16* p1; int ld1; const u16* p2; int ld2; int ksplit; };

template <class Epi>
__device__ __forceinline__ void gemm_phase(unsigned char* smem_raw, ASrc a, const u16* __restrict__ Bt, int M, int N, int K, Epi epi) {
  u16* sA = (u16*)smem_raw;
  u16* sB = sA + 2 * 128 * LDSROW;
  const int tid = threadIdx.x, lane = tid & 63, wid = tid >> 6;
  const int wr = wid >> 1, wc = wid & 1, fr = lane & 15, fq = lane >> 4;
  const int Mt = M / 128, Nt = N / 128, nk = K / 64;
  const int lrow = tid >> 3, lkc = tid & 7;
  const int wsw = lkc ^ ((lrow >> 1) & 7);
  const int rsw = fq ^ (fr >> 1);
  const int nx = (gridDim.x & 7) ? 1 : 8;
  const int xcd = (nx == 8) ? (blockIdx.x & 7) : 0, lb = (nx == 8) ? (blockIdx.x >> 3) : blockIdx.x, lstep = gridDim.x / nx;
  const int tm0 = (Mt * xcd) / nx, mh = (Mt * (xcd + 1)) / nx - tm0;
  for (int tl = lb; tl < mh * Nt; tl += lstep) {
    const int pn = tl / (mh * 8), rem = tl - pn * (mh * 8);
    const int wp = min(8, Nt - pn * 8);
    const int tm = tm0 + rem / wp, tn = pn * 8 + rem % wp;
    f32x4 acc[4][4];
#pragma unroll
    for (int i = 0; i < 4; ++i)
#pragma unroll
      for (int j = 0; j < 4; ++j) acc[i][j] = (f32x4){0.f, 0.f, 0.f, 0.f};
    auto gissue = [&](int kt, int buf) {
      const int k0 = kt * 64;
      const u16* ap; int lda;
      if (k0 < a.ksplit) { ap = a.p1 + k0; lda = a.ld1; } else { ap = a.p2 + (k0 - a.ksplit); lda = a.ld2; }
#pragma unroll
      for (int i = 0; i < 4; ++i) {
        const int r = lrow + i * 32;
        __builtin_amdgcn_global_load_lds((const unsigned*)(ap + (size_t)(tm * 128 + r) * lda + wsw * 8),
                                         (LAS unsigned*)(sA + buf * 128 * LDSROW + r * LDSROW + lkc * 8), 16, 0, 0);
        __builtin_amdgcn_global_load_lds((const unsigned*)(Bt + (size_t)(tn * 128 + r) * K + k0 + wsw * 8),
                                         (LAS unsigned*)(sB + buf * 128 * LDSROW + r * LDSROW + lkc * 8), 16, 0, 0);
      }
    };
    gissue(0, 0);
    asm volatile("s_waitcnt vmcnt(0)" ::: "memory");
    __syncthreads();
    for (int kt = 0; kt < nk; ++kt) {
      const int buf = kt & 1;
      if (kt + 1 < nk) gissue(kt + 1, buf ^ 1);
      const u16* pa = sA + buf * 128 * LDSROW + (wr * 64 + fr) * LDSROW;
      const u16* pb = sB + buf * 128 * LDSROW + (wc * 64 + fr) * LDSROW;
      bf16x8 af[2][4], bfr[2][4];
#pragma unroll
      for (int ks = 0; ks < 2; ++ks)
#pragma unroll
        for (int i = 0; i < 4; ++i) {
          af[ks][i] = *(const bf16x8*)(pa + i * 16 * LDSROW + ((rsw ^ (ks * 4)) * 8));
          bfr[ks][i] = *(const bf16x8*)(pb + i * 16 * LDSROW + ((rsw ^ (ks * 4)) * 8));
        }
      __builtin_amdgcn_s_setprio(1);
#pragma unroll
      for (int ks = 0; ks < 2; ++ks)
#pragma unroll
        for (int i = 0; i < 4; ++i)
#pragma unroll
          for (int j = 0; j < 4; ++j)
            acc[i][j] = __builtin_amdgcn_mfma_f32_16x16x32_bf16(bfr[ks][j], af[ks][i], acc[i][j], 0, 0, 0);
      __builtin_amdgcn_s_setprio(0);
      asm volatile("s_waitcnt vmcnt(0)" ::: "memory");
      __syncthreads();
    }
#pragma unroll
    for (int i = 0; i < 4; ++i)
#pragma unroll
      for (int j = 0; j < 4; ++j)
        epi(tm * 128 + wr * 64 + i * 16 + fr, tn * 128 + wc * 64 + j * 16 + fq * 4, acc[i][j]);
  }
}

struct EpiInProj0 {
  u16* prw; u16* phy;
  __device__ __forceinline__ void operator()(int row, int col, f32x4 v) const {
    uint2 pk = make_uint2(pack2(v[0], v[1]), pack2(v[2], v[3]));
    if (col < 1792) *(uint2*)(prw + (size_t)row * 1792 + col) = pk;
    else *(uint2*)(phy + (size_t)row * 1536 + (col - 1792)) = pk;
  }
};
struct EpiInProj1 {
  u16* pqkv; u16* pz; float* pab; u16* halo;
  __device__ __forceinline__ void operator()(int row, int col, f32x4 v) const {
    if (col < 4096) {
      uint2 pk = make_uint2(pack2(v[0], v[1]), pack2(v[2], v[3]));
      if (col < 3072) {
        *(uint2*)(pqkv + (size_t)row * 3072 + col) = pk;
        const int rl = row & 127;
        if (rl == 0 || rl == 127) *(uint2*)(halo + (size_t)((row >> 7) * 2 + (rl ? 1 : 0)) * 3072 + col) = pk;
      }
      else *(uint2*)(pz + (size_t)row * 1024 + (col - 3072)) = pk;
    } else if (col < 4128) {
      *(float4*)(pab + (size_t)row * 32 + (col - 4096)) = make_float4(v[0], v[1], v[2], v[3]);
    }
  }
};
struct EpiRelu2 {
  u16* u;
  __device__ __forceinline__ void operator()(int row, int col, f32x4 v) const {
    float a = fmaxf(v[0], 0.f), b = fmaxf(v[1], 0.f), c = fmaxf(v[2], 0.f), d = fmaxf(v[3], 0.f);
    *(uint2*)(u + (size_t)row * 4096 + col) = make_uint2(pack2(a * a, b * b), pack2(c * c, d * d));
  }
};
struct EpiResid {
  const float* xin_lat; const float* xin_ctx; float* xout_lat; float* xout_ctx; const float* modv;
  __device__ __forceinline__ void operator()(int row, int col, f32x4 v) const {
    const float* xi; float* xo; int mr;
    if (row < MLAT) { mr = row >> 11; xi = xin_lat + (size_t)row * 1024; xo = xout_lat + (size_t)row * 1024; }
    else { mr = 8; xi = xin_ctx + (size_t)(row - MLAT) * 1024; xo = xout_ctx + (size_t)(row - MLAT) * 1024; }
    float4 x = *(const float4*)(xi + col);
    float4 m = *(const float4*)(modv + mr * 6144 + col);
    *(float4*)(xo + col) = make_float4(x.x + m.x * v[0], x.y + m.y * v[1], x.z + m.z * v[2], x.w + m.w * v[3]);
  }
};

__device__ __forceinline__ void norm_phase(const float* xlat, const float* xctx, int nrows, const float* nw, const float* modl, int shiftc, int scalec, u16* h) {
  const int lane = threadIdx.x & 63, wid = threadIdx.x >> 6;
  for (int row = blockIdx.x * 4 + wid; row < nrows; row += gridDim.x * 4) {
    const float* src; int mr;
    if (row < MLAT) { src = xlat + (size_t)row * 1024; mr = row >> 11; } else { src = xctx + (size_t)(row - MLAT) * 1024; mr = 8; }
    float4 v[4]; float ss = 0.f;
#pragma unroll
    for (int i = 0; i < 4; ++i) { v[i] = *(const float4*)(src + (i * 64 + lane) * 4); ss += v[i].x * v[i].x + v[i].y * v[i].y + v[i].z * v[i].z + v[i].w * v[i].w; }
    ss = wave_sum(ss);
    const float rs = rsqrtf(ss * (1.f / 1024.f) + 1e-6f);
    const float* sh = modl + mr * 6144 + shiftc * 1024; const float* sc = modl + mr * 6144 + scalec * 1024;
#pragma unroll
    for (int i = 0; i < 4; ++i) {
      int c = (i * 64 + lane) * 4;
      float4 w = *(const float4*)(nw + c), s = *(const float4*)(sh + c), g = *(const float4*)(sc + c);
      float a = v[i].x * rs * w.x * (1.f + g.x) + s.x, b = v[i].y * rs * w.y * (1.f + g.y) + s.y;
      float cc = v[i].z * rs * w.z * (1.f + g.z) + s.z, d = v[i].w * rs * w.w * (1.f + g.w) + s.w;
      *(uint2*)(h + (size_t)row * 1024 + c) = make_uint2(pack2(a, b), pack2(cc, d));
    }
  }
}

__device__ __forceinline__ void wconv_item(float* tile  , const float* __restrict__ src, int K, int N, int Npad, u16* dst, int item) {
  const int tid = threadIdx.x;
  const int ntn = Npad / 64;
  const int tk = item / ntn, tn = item % ntn;
#pragma unroll
  for (int i = 0; i < 16; ++i) {
    int k = i * 4 + (tid >> 6), n = tid & 63;
    int gn = tn * 64 + n;
    tile[k * 65 + n] = (gn < N) ? src[(size_t)(tk * 64 + k) * N + gn] : 0.f;
  }
  __syncthreads();
#pragma unroll
  for (int i = 0; i < 2; ++i) {
    int c = tid + i * 256, n = c >> 3, kg = c & 7;
    unsigned p[4];
#pragma unroll
    for (int j = 0; j < 4; ++j) p[j] = pack2(tile[(kg * 8 + 2 * j) * 65 + n], tile[(kg * 8 + 2 * j + 1) * 65 + n]);
    *(uint4*)(dst + (size_t)(tn * 64 + n) * K + tk * 64 + kg * 8) = make_uint4(p[0], p[1], p[2], p[3]);
  }
  __syncthreads();
}
__device__ __forceinline__ void wconv_layer(float* tile, CP P, int layer, int gstart, int gstride) {
  unsigned char* ws = P->ws;
  const float* s_in; int n_in, np_in; const float* s_out;
  if (layer == 0) { s_in = P->in[I_ABIN]; n_in = 3328; np_in = 3328; s_out = P->in[I_ABOUT]; }
  else { s_in = P->in[I_DNIN]; n_in = 4128; np_in = 4224; s_out = P->in[I_DNOUT]; }
  const float* s_w1 = P->in[I_W1] + (size_t)layer * 1024 * 4096;
  const float* s_w2 = P->in[I_W2] + (size_t)layer * 4096 * 1024;
  const int n0 = 16 * (np_in / 64), n1 = 16 * 16, n2 = 16 * 64, n3 = 64 * 16;
  const int n4 = (layer == 0) ? 48 : 0;
  for (int it = gstart; it < n0 + n1 + n2 + n3 + n4; it += gstride) {
    if (it >= n0 + n1 + n2 + n3) {
      const int q = it - (n0 + n1 + n2 + n3);
      if (q < 16) wconv_item(tile, P->in[I_WUP] + (size_t)(q >> 3) * 64 * 512, 64, 512, 512, (u16*)(ws + W_LRW) + (size_t)(q >> 3) * 512 * 64, q & 7);
      else if (q < 32) wconv_item(tile, P->in[I_AUP] + (size_t)((q - 16) >> 3) * 64 * 512, 64, 512, 512, (u16*)(ws + W_LRA) + (size_t)((q - 16) >> 3) * 512 * 64, q & 7);
      else wconv_item(tile, P->in[I_GUP], 128, 512, 512, (u16*)(ws + W_LRG), q - 32);
    }
    else if (it < n0) wconv_item(tile, s_in, 1024, n_in, np_in, (u16*)(ws + W_IN), it);
    else if (it < n0 + n1) wconv_item(tile, s_out, 1024, 1024, 1024, (u16*)(ws + W_OUT), it - n0);
    else if (it < n0 + n1 + n2) wconv_item(tile, s_w1, 1024, 4096, 4096, (u16*)(ws + W_1), it - n0 - n1);
    else wconv_item(tile, s_w2, 4096, 1024, 1024, (u16*)(ws + W_2), it - n0 - n1 - n2);
  }
}

__device__ __forceinline__ void modv_item(float* lds, CP P, int item) {
  const int tid = threadIdx.x;
  const int l = item / 192, n0 = (item % 192) * 32;
  float* sc = lds;
  float* red = lds + 9 * 1024;
  for (int e = tid; e < 9 * 1024; e += NTHR) {
    int r = e >> 10, k = e & 1023;
    float cv = (r < 8) ? P->in[I_C][r * 1024 + k] : P->in[I_CCTX][k];
    sc[e] = siluf_(cv);
  }
  __syncthreads();
  const int col = tid & 31, kp = tid >> 5;
  const float* w = P->in[I_ADAW] + (size_t)l * 1024 * 6144 + n0 + col;
  float acc[9];
#pragma unroll
  for (int r = 0; r < 9; ++r) acc[r] = 0.f;
#pragma unroll 4
  for (int k = kp * 128; k < kp * 128 + 128; k += 4) {
    float w0 = w[(size_t)k * 6144], w1 = w[(size_t)(k + 1) * 6144], w2 = w[(size_t)(k + 2) * 6144], w3 = w[(size_t)(k + 3) * 6144];
#pragma unroll
    for (int r = 0; r < 9; ++r) {
      float4 s = *(const float4*)(sc + r * 1024 + k);
      acc[r] += s.x * w0 + s.y * w1 + s.z * w2 + s.w * w3;
    }
  }
#pragma unroll
  for (int r = 0; r < 9; ++r) red[(kp * 9 + r) * 32 + col] = acc[r];
  __syncthreads();
  float* modv = (float*)(P->ws + OFF_SMALL + S_MODV);
  for (int e = tid; e < 9 * 32; e += NTHR) {
    int r = e >> 5, c = e & 31;
    float s = 0.f;
#pragma unroll
    for (int q = 0; q < 8; ++q) s += red[(q * 9 + r) * 32 + c];
    modv[(size_t)l * 9 * 6144 + r * 6144 + n0 + c] = s + P->in[I_ADAB][l * 6144 + n0 + c];
  }
  __syncthreads();
}

__device__ __forceinline__ void h3_item(float* lds, CP P, int item) {
  const int tid = threadIdx.x, p = tid >> 6, j = tid & 63;
  int L, pos, obase;
  if (item < 512) { L = 2048; pos = item * 4 + p; obase = 0; } else { L = 256; pos = (item - 512) * 4 + p; obase = 2048; }
  float* z = lds;
  float* ha = lds + 256;
  float* hb = lds + 512;
  if (j < 33) {
    float val;
    if (j == 0) val = (float)pos / (float)(L - 1);
    else {
      int bi = (j - 1) & 15;
      float f = 1e-4f + (float)bi * ((15.f - 1e-4f) / 15.f);
      float w = 6.283185307179586f * (float)pos / (float)L;
      float ang = f * w;
      val = (j <= 16) ? cosf(ang) : -sinf(ang);
    }
    z[p * 64 + j] = val;
  }
  __syncthreads();
  const float fq = P->in[I_FREQ][j];
  {
    float s = P->in[I_FB1][j];

#pragma unroll 4
    for (int i = 0; i < 33; ++i) s += z[p * 64 + i] * P->in[I_FW1][i * 64 + j];
    ha[p * 64 + j] = sinf(fq * s);
  }
  __syncthreads();
  {
    float s = P->in[I_FB2][j];

#pragma unroll 4
    for (int i = 0; i < 64; ++i) s += ha[p * 64 + i] * P->in[I_FW2][i * 64 + j];
    hb[p * 64 + j] = sinf(fq * s);
  }
  __syncthreads();
  {
    float s = P->in[I_FB3][j];

#pragma unroll 4
    for (int i = 0; i < 64; ++i) s += hb[p * 64 + i] * P->in[I_FW3][i * 64 + j];
    float* H3 = (float*)(P->ws + OFF_SMALL + S_H3);
    H3[(size_t)(obase + pos) * 64 + j] = sinf(fq * s);
  }
  __syncthreads();
}

__device__ __forceinline__ void kun_item(float* lds, CP P, int item) {
  const int tid = threadIdx.x;
  int L, pos0, hbase, seq; float* filt;
  if (item < 256) { L = 2048; pos0 = item * 8; hbase = 0; seq = 0; filt = (float*)(P->ws + OFF_FILT); }
  else { L = 256; pos0 = (item - 256) * 8; hbase = 2048; seq = 1; filt = (float*)(P->ws + OFF_FILTC); }
  const float* H3 = (const float*)(P->ws + OFF_SMALL + S_H3);
  float* hs = lds;
  for (int e = tid; e < 512; e += NTHR) { int p = e >> 6, i = e & 63; hs[i * 8 + p] = H3[(size_t)(hbase + pos0 + p) * 64 + i]; }
  __syncthreads();
  float acc[4][8];
#pragma unroll
  for (int q = 0; q < 4; ++q)
#pragma unroll
    for (int p = 0; p < 8; ++p) acc[q][p] = 0.f;
  const float* w4 = P->in[I_FW4];
  for (int i = 0; i < 64; ++i) {
    float4 h0 = *(const float4*)(hs + i * 8), h1 = *(const float4*)(hs + i * 8 + 4);
#pragma unroll
    for (int q = 0; q < 4; ++q) {
      float w = w4[i * 1024 + tid + q * 256];
      acc[q][0] += h0.x * w; acc[q][1] += h0.y * w; acc[q][2] += h0.z * w; acc[q][3] += h0.w * w;
      acc[q][4] += h1.x * w; acc[q][5] += h1.y * w; acc[q][6] += h1.z * w; acc[q][7] += h1.w * w;
    }
  }
  float* hnorm = (float*)(P->ws + OFF_SMALL + S_HNORM);
  const float lo = -3.0701134573253945f, hi = -15.350567286626973f;
#pragma unroll
  for (int q = 0; q < 4; ++q) {
    int col = tid + q * 256, half = col >> 9, c = col & 511;
    float delta = fabsf(lo + (hi - lo) * ((float)c / 511.f));
    float asum = 0.f;
#pragma unroll
    for (int p = 0; p < 8; ++p) {
      int j = pos0 + p;
      float t = (float)j / (float)(L - 1);
      float val = acc[q][p] * __expf(-t * delta);
      if (half == 0) { filt[(size_t)c * (2 * L) + (j + L - 1)] = val; asum += fabsf(val); }
      else if (j >= 1) { filt[(size_t)c * (2 * L) + (L - 1 - j)] = val; asum += fabsf(val); }
    }
    atomicAdd(&hnorm[seq * 512 + c], asum);
  }
  __syncthreads();
}

__device__ __forceinline__ void seq_of_row(int row, int& sstart, int& slen) {
  if (row < MLAT) { sstart = row & ~2047; slen = 2048; } else { sstart = MLAT + ((row - MLAT) & ~255); slen = 256; }
}

__device__ __forceinline__ void lrprep_item(CP P, int item) {
  const int tid = threadIdx.x, lane = tid & 63;
  const int row0 = item * 16;
  int sstart, slen; seq_of_row(row0, sstart, slen);
  const int send = sstart + slen;
  unsigned char* ws = P->ws;
  const u16* prw = (const u16*)(ws + L0_PRW);
  u16* LR = (u16*)(ws + L0_LR);
  float* RN = (float*)(ws + OFF_SMALL + S_RNORM);
  {
    const int col = 1536 + tid;
    const float mu = P->in[I_MU][col];
    u16 rv[18];
#pragma unroll
    for (int t = 0; t < 18; ++t) { int rr = row0 - 1 + t; rr = rr < sstart ? sstart : (rr >= send ? send - 1 : rr); rv[t] = prw[(size_t)rr * 1792 + col]; }
#pragma unroll
    for (int t = 0; t < 16; ++t) {
      float prev = (row0 + t - 1 >= sstart) ? bf2f(rv[t]) : 0.f, cur = bf2f(rv[t + 1]), nxt = (row0 + t + 1 < send) ? bf2f(rv[t + 2]) : 0.f;
      float s = cur + mu * (0.5f * (prev + nxt) - cur);
      float o = (tid < 64) ? tanhf(s) : ((tid < 128) ? s : sigmoidf_(s));
      LR[(size_t)(row0 + t) * 256 + tid] = f2bf(o);
    }
  }
#pragma unroll
  for (int jj = 0; jj < 2; ++jj) {
    const int j = tid + jj * 256, head = j >> 6;
    const float muk = P->in[I_MU][512 + j], kkk = P->in[I_KK][j];
    u16 kv[18];
#pragma unroll
    for (int t = 0; t < 18; ++t) { int rr = row0 - 1 + t; rr = rr < sstart ? sstart : (rr >= send ? send - 1 : rr); kv[t] = prw[(size_t)rr * 1792 + 512 + j]; }
#pragma unroll
    for (int t = 0; t < 16; ++t) {
      float kp = (row0 + t - 1 >= sstart) ? bf2f(kv[t]) : 0.f, kc = bf2f(kv[t + 1]), kn = (row0 + t + 1 < send) ? bf2f(kv[t + 2]) : 0.f;
      float ks = kc + muk * (0.5f * (kp + kn) - kc);
      float kq = ks * kkk; kq = wave_sum(kq * kq);
      if (lane == 0) RN[(size_t)(row0 + t) * 8 + head] = rsqrtf(kq + 1e-6f);
    }
  }
}

struct EpiLrW {
  u16* om0; u16* om1; const float* w0;
  __device__ __forceinline__ void operator()(int row, int col, f32x4 v) const {
    float o[4];
#pragma unroll
    for (int e = 0; e < 4; ++e) {
      float z = w0[col + e] + v[e];
      float wlog = -softplusf_(-z) - 0.5f;
      o[e] = -expm1f(-__expf(wlog));
    }
    u16* dst = (col < 512) ? om0 : om1;
    *(uint2*)(dst + (size_t)row * 512 + (col & 511)) = make_uint2(pack2(o[0], o[1]), pack2(o[2], o[3]));
  }
};
struct EpiLrA {
  u16* a0; u16* a1; const float* b0;
  __device__ __forceinline__ void operator()(int row, int col, f32x4 v) const {
    float o[4];
#pragma unroll
    for (int e = 0; e < 4; ++e) o[e] = sigmoidf_(b0[col + e] + v[e]);
    u16* dst = (col < 512) ? a0 : a1;
    *(uint2*)(dst + (size_t)row * 512 + (col & 511)) = make_uint2(pack2(o[0], o[1]), pack2(o[2], o[3]));
  }
};
struct EpiLrG {
  u16* g;
  __device__ __forceinline__ void operator()(int row, int col, f32x4 v) const {
    *(uint2*)(g + (size_t)row * 512 + col) = make_uint2(pack2(v[0], v[1]), pack2(v[2], v[3]));
  }
};

__device__ __forceinline__ void hyprep_item(CP P, int item) {
  const int tid = threadIdx.x;
  const int row0 = item * 16;
  int sstart, slen; seq_of_row(row0, sstart, slen);
  const int send = sstart + slen;
  const u16* phy = (const u16*)(P->ws + L0_PHY);
  u16* S = (u16*)(P->ws + L0_S); u16* X0 = (u16*)(P->ws + L0_X0C);
  const float* cw = P->in[I_HCW]; const float* cb = P->in[I_HCB];
  for (int cc = 0; cc < 2; ++cc) {
    const int c = tid + cc * 256;
    float w[3][3], bsv[3], pv[3], cv[3];
#pragma unroll
    for (int g = 0; g < 3; ++g) {
      int col = g * 512 + c;
      w[g][0] = cw[col]; w[g][1] = cw[1536 + col]; w[g][2] = cw[3072 + col]; bsv[g] = cb[col];
      pv[g] = (row0 - 1 >= sstart) ? bf2f(phy[(size_t)(row0 - 1) * 1536 + col]) : 0.f;
      cv[g] = bf2f(phy[(size_t)row0 * 1536 + col]);
    }
    unsigned sp[8];
#pragma unroll
    for (int t = 0; t < 16; ++t) {
      int rn = row0 + t + 1; float o[3];
#pragma unroll
      for (int g = 0; g < 3; ++g) {
        float nx = (rn < send) ? bf2f(phy[(size_t)rn * 1536 + g * 512 + c]) : 0.f;
        o[g] = w[g][0] * pv[g] + w[g][1] * cv[g] + w[g][2] * nx + bsv[g];
        pv[g] = cv[g]; cv[g] = nx;
      }
      const unsigned sb = f2bf(o[1] * o[2]);
      if (t & 1) sp[t >> 1] |= sb << 16; else sp[t >> 1] = sb;
      X0[(size_t)(row0 + t) * 512 + c] = f2bf(o[0]);
    }
    *(uint4*)(S + (size_t)c * MTOT + row0) = make_uint4(sp[0], sp[1], sp[2], sp[3]);
    *(uint4*)(S + (size_t)c * MTOT + row0 + 8) = make_uint4(sp[4], sp[5], sp[6], sp[7]);
  }
}

__device__ __forceinline__ void rwscan_item(float* lds, CP P, int item) {
  const int tid = threadIdx.x;
  const int half = item & 1, dir = (item >> 1) & 1, h = (item >> 2) & 7, b = item >> 5;
  const int kq = tid & 7, rl = tid >> 3;
  unsigned char* ws = P->ws;
  const u16* prw = (const u16*)(ws + L0_PRW);
  const u16* Ad = (const u16*)((unsigned char*)P->out + (dir ? DO_A1 : DO_A0));
  const u16* OMd = dir ? (const u16*)(ws + L0_OM1) : (const u16*)((unsigned char*)P->out + DO_OM0);
  const float* RN = (const float*)(ws + OFF_SMALL + S_RNORM);
  u16* Y = (u16*)(ws + (dir ? L0_Y1 : L0_Y0));
  const int SSTR = 352, BUFSZ = 16 * 352;
  float* cst = lds + 2 * BUFSZ;
  __syncthreads();
  if (tid < 64) {
    const int cj = h * 64 + tid;
    cst[tid] = P->in[I_MU][cj]; cst[64 + tid] = P->in[I_MU][512 + cj]; cst[128 + tid] = P->in[I_KK][cj]; cst[192 + tid] = P->in[I_KA][cj];
    if (tid < 32) cst[256 + tid] = P->in[I_MU][1024 + h * 64 + half * 32 + tid];
  }
  const int sst = tid >> 4, sc4 = tid & 15;
  const int j0 = h * 64 + sc4 * 4;
  const int cv0 = 1024 + h * 64 + half * 32 + sc4 * 2;
  float sx[8];
#pragma unroll
  for (int j = 0; j < 8; ++j) sx[j] = 0.f;
  for (int seq = 0; seq < 2; ++seq) {
    const int Ls = seq ? 2048 : 256;
    const int rowbase = seq ? b * 2048 : MLAT + b * 256;
    const int nchunk = Ls / 16;
    uint2 R0, R1, R2, K0, K1, K2, AA, OO; unsigned V0, V1, V2; float rn = 0.f; bool hp = false, hn = false;
    auto gl = [&](int c) {
      int i = c * 16 + sst; int t = dir ? (Ls - 1 - i) : i; size_t row = rowbase + t;
      hp = t > 0; hn = t < Ls - 1;
      const size_t rp = hp ? row - 1 : row, rx = hn ? row + 1 : row;
      const u16* p = prw + row * 1792; const u16* pp = prw + rp * 1792; const u16* px = prw + rx * 1792;
      R1 = *(const uint2*)(p + j0); K1 = *(const uint2*)(p + 512 + j0);
      R0 = *(const uint2*)(pp + j0); K0 = *(const uint2*)(pp + 512 + j0);
      R2 = *(const uint2*)(px + j0); K2 = *(const uint2*)(px + 512 + j0);
      AA = *(const uint2*)(Ad + row * 512 + j0); OO = *(const uint2*)(OMd + row * 512 + j0);
      rn = RN[row * 8 + h];
      V1 = *(const unsigned*)(p + cv0); V0 = *(const unsigned*)(pp + cv0); V2 = *(const unsigned*)(px + cv0);
    };
    auto sw = [&](int buf) {
      float* sp = lds + buf * BUFSZ + sst * SSTR;
      const float fp = hp ? 1.f : 0.f, fn = hn ? 1.f : 0.f;
      const unsigned r0[2] = {R0.x, R0.y}, r1[2] = {R1.x, R1.y}, r2[2] = {R2.x, R2.y};
      const unsigned k0[2] = {K0.x, K0.y}, k1[2] = {K1.x, K1.y}, k2[2] = {K2.x, K2.y};
      const unsigned aa[2] = {AA.x, AA.y}, oo[2] = {OO.x, OO.y};
      const float4 mur4 = *(const float4*)(cst + sc4 * 4), muk4 = *(const float4*)(cst + 64 + sc4 * 4);
      const float4 kkk4 = *(const float4*)(cst + 128 + sc4 * 4), ka4 = *(const float4*)(cst + 192 + sc4 * 4);
      const float mur[4] = {mur4.x, mur4.y, mur4.z, mur4.w}, muk[4] = {muk4.x, muk4.y, muk4.z, muk4.w};
      const float kkk[4] = {kkk4.x, kkk4.y, kkk4.z, kkk4.w}, ka[4] = {ka4.x, ka4.y, ka4.z, ka4.w};
      float okk[4], ow[4], ob[4], okd[4], orr[4];
#pragma unroll
      for (int e = 0; e < 4; ++e) {
        const int q = e >> 1, sh = (e & 1) ? 0 : 16;
        auto ex = [&](unsigned u) { return __uint_as_float((u << sh) & 0xffff0000u); };
        float rc = ex(r1[q]), kc = ex(k1[q]);
        float rs = rc + mur[e] * (0.5f * (fp * ex(r0[q]) + fn * ex(r2[q])) - rc);
        float ks = kc + muk[e] * (0.5f * (fp * ex(k0[q]) + fn * ex(k2[q])) - kc);
        float a = ex(aa[q]), om = ex(oo[q]);
        float kk = ks * kkk[e] * rn;
        okk[e] = kk; ow[e] = 1.f - om; ob[e] = a * kk; okd[e] = ks * (1.f + (a - 1.f) * ka[e]); orr[e] = rs;
      }
      *(float4*)(sp + sc4 * 4) = make_float4(okk[0], okk[1], okk[2], okk[3]);
      *(float4*)(sp + 64 + sc4 * 4) = make_float4(ow[0], ow[1], ow[2], ow[3]);
      *(float4*)(sp + 128 + sc4 * 4) = make_float4(ob[0], ob[1], ob[2], ob[3]);
      *(float4*)(sp + 192 + sc4 * 4) = make_float4(okd[0], okd[1], okd[2], okd[3]);
      *(float4*)(sp + 256 + sc4 * 4) = make_float4(orr[0], orr[1], orr[2], orr[3]);
      {
        const float2 muv2 = *(const float2*)(cst + 256 + sc4 * 2);
        float va = __uint_as_float(V1 << 16), vb = __uint_as_float(V1 & 0xffff0000u);
        float o0 = va + muv2.x * (0.5f * (fp * __uint_as_float(V0 << 16) + fn * __uint_as_float(V2 << 16)) - va);
        float o1 = vb + muv2.y * (0.5f * (fp * __uint_as_float(V0 & 0xffff0000u) + fn * __uint_as_float(V2 & 0xffff0000u)) - vb);
        *(float2*)(sp + 320 + sc4 * 2) = make_float2(o0, o1);
      }
    };
    gl(0);
    __syncthreads();
    sw(0);
    __syncthreads();
    for (int c = 0; c < nchunk; ++c) {
      const int buf = c & 1;
      if (c + 1 < nchunk) gl(c + 1);
      float ykA = 0.f, ykB = 0.f;
      float4 rp0 = make_float4(0.f, 0.f, 0.f, 0.f), rp1 = make_float4(0.f, 0.f, 0.f, 0.f);
#pragma unroll
      for (int st = 0; st < 16; ++st) {
        const float* sp = lds + buf * BUFSZ + st * SSTR + kq * 8;
        const float4 k0 = *(const float4*)(sp), k1 = *(const float4*)(sp + 4);
        const float4 w0 = *(const float4*)(sp + 64), w1 = *(const float4*)(sp + 68);
        const float4 b0 = *(const float4*)(sp + 128), b1 = *(const float4*)(sp + 132);
        const float4 d0 = *(const float4*)(sp + 192), d1 = *(const float4*)(sp + 196);
        const float4 r0 = *(const float4*)(sp + 256), r1 = *(const float4*)(sp + 260);
        const float vv = lds[buf * BUFSZ + st * SSTR + 320 + rl];
        float pa = ((sx[0] * k0.x + sx[1] * k0.y) + (sx[2] * k0.z + sx[3] * k0.w)) + ((sx[4] * k1.x + sx[5] * k1.y) + (sx[6] * k1.z + sx[7] * k1.w));
        float py = ((sx[0] * rp0.x + sx[1] * rp0.y) + (sx[2] * rp0.z + sx[3] * rp0.w)) + ((sx[4] * rp1.x + sx[5] * rp1.y) + (sx[6] * rp1.z + sx[7] * rp1.w));
        red8d(pa, py);
        if (st > 0) { const int pv = st - 1; if (pv < 8) ykA = (kq == pv) ? py : ykA; else ykB = (kq == pv - 8) ? py : ykB; }
        const float sa = -pa;
        sx[0] = sx[0] * w0.x + (sa * b0.x + vv * d0.x); sx[1] = sx[1] * w0.y + (sa * b0.y + vv * d0.y);
        sx[2] = sx[2] * w0.z + (sa * b0.z + vv * d0.z); sx[3] = sx[3] * w0.w + (sa * b0.w + vv * d0.w);
        sx[4] = sx[4] * w1.x + (sa * b1.x + vv * d1.x); sx[5] = sx[5] * w1.y + (sa * b1.y + vv * d1.y);
        sx[6] = sx[6] * w1.z + (sa * b1.z + vv * d1.z); sx[7] = sx[7] * w1.w + (sa * b1.w + vv * d1.w);
        rp0 = r0; rp1 = r1;
      }
      {
        float py = ((sx[0] * rp0.x + sx[1] * rp0.y) + (sx[2] * rp0.z + sx[3] * rp0.w)) + ((sx[4] * rp1.x + sx[5] * rp1.y) + (sx[6] * rp1.z + sx[7] * rp1.w));
        float du = 0.f;
        red8d(py, du);
        ykB = (kq == 7) ? py : ykB;
      }
      {
        int i = c * 16 + kq; int t = dir ? (Ls - 1 - i) : i;
        Y[(size_t)(rowbase + t) * 512 + h * 64 + half * 32 + rl] = f2bf(ykA);
        i += 8; t = dir ? (Ls - 1 - i) : i;
        Y[(size_t)(rowbase + t) * 512 + h * 64 + half * 32 + rl] = f2bf(ykB);
      }
      if (c + 1 < nchunk) sw(buf ^ 1);
      lds_barrier();
    }
  }
}

typedef __attribute__((ext_vector_type(4))) unsigned u32x4;
__device__ __forceinline__ void hymfma_item(unsigned char* smem, CP P, int item) {
  const int tid = threadIdx.x, lane = tid & 63, w = tid >> 6;
  const int fr = lane & 15, fq = lane >> 4;
  const bool lat = item < 512;
  const int c = lat ? item : item - 512;
  const int L = lat ? 2048 : 256, nb = L >> 5, RS = L + 8;
  unsigned char* ws = P->ws;
  const u16* ST = (const u16*)(ws + L0_S) + (size_t)c * MTOT + (lat ? 0 : MLAT);
  u16* CT = (u16*)(ws + L0_HY) + (size_t)c * MTOT + (lat ? 0 : MLAT);
  const float* FT = lat ? (const float*)(ws + OFF_FILT) + (size_t)c * 4096 : (const float*)(ws + OFF_FILTC) + (size_t)c * 512;
  u16* sS = (u16*)smem;
  u16* rk0 = (u16*)(smem + 32896);
  u16* rk1 = (u16*)(smem + 32896 + 8192);
  __syncthreads();
  for (int ch = tid; ch < L; ch += NTHR) {
    const int b = ch / (L >> 3), s8 = ch % (L >> 3);
    *(uint4*)(sS + b * RS + s8 * 8) = *(const uint4*)(ST + (size_t)b * L + s8 * 8);
  }
  for (int e = tid; e < 2 * L - 1; e += NTHR) {
    const u16 v = f2bf(FT[e]);
    const int i = 2 * L - 2 - e;
    rk0[i] = v;
    if (i >= 1) rk1[i - 1] = v;
  }
  if (tid == 0) rk1[2 * L - 2] = 0;
  __syncthreads();
  const int npairs = lat ? 8 : 1;
  const int tbase = lat ? 16 * w : (4 * (w >> 1) + (w & 1));
  f32x4 acc[8][2];
#pragma unroll
  for (int p = 0; p < 8; ++p) { acc[p][0] = (f32x4){0.f, 0.f, 0.f, 0.f}; acc[p][1] = (f32x4){0.f, 0.f, 0.f, 0.f}; }
  const int cg = fr >> 3, bb = fr & 7;
  const int t1last = tbase + 4 * ((npairs - 1) >> 1) + ((npairs - 1) & 1) + 2;
  const u16* rsel = (fr & 1) ? rk0 : rk1;
  const int ioff = (L - 1) - fr + 8 * fq - ((fr & 1) ? 0 : 1);
  for (int dl = tbase - (nb - 1); dl <= t1last; ++dl) {
    const int i0 = ioff - 32 * dl;
    const unsigned* pa0 = (const unsigned*)(rsel + i0);
    const unsigned* pa1 = (const unsigned*)(rsel + i0 - 16);
    u32x4 a0v = (u32x4){pa0[0], pa0[1], pa0[2], pa0[3]};
    u32x4 a1v = (u32x4){pa1[0], pa1[1], pa1[2], pa1[3]};
    const bf16x8 A0 = __builtin_bit_cast(bf16x8, a0v), A1 = __builtin_bit_cast(bf16x8, a1v);
#pragma unroll
    for (int p = 0; p < 8; ++p) {
      if (p < npairs) {
        const int t1a = tbase + 4 * (p >> 1) + (p & 1);
        const int s1a = t1a - dl;
        if (s1a < nb && s1a + 2 >= 0) {
          const int s1 = s1a + 2 * cg;
          const bool ok = (s1 >= 0) && (s1 < nb);
          const int s1c = ok ? s1 : 0;
          u32x4 bv = *(const u32x4*)(sS + bb * RS + 32 * s1c + fq * 8);
          if (!ok) bv = (u32x4){0u, 0u, 0u, 0u};
          const bf16x8 B = __builtin_bit_cast(bf16x8, bv);
          acc[p][0] = __builtin_amdgcn_mfma_f32_16x16x32_bf16(A0, B, acc[p][0], 0, 0, 0);
          acc[p][1] = __builtin_amdgcn_mfma_f32_16x16x32_bf16(A1, B, acc[p][1], 0, 0, 0);
        }
      }
    }
  }
  const float inv = 1.f / ((const float*)(ws + OFF_SMALL + S_HNORM))[(lat ? 0 : 512) + c];
  const float skip = P->in[I_SKIP][c];
#pragma unroll
  for (int p = 0; p < 8; ++p) {
    if (p < npairs) {
      const int t1 = tbase + 4 * (p >> 1) + (p & 1) + 2 * cg;
#pragma unroll
      for (int th = 0; th < 2; ++th) {
        const int t = 32 * t1 + th * 16 + fq * 4;
        const uint2 sv = *(const uint2*)(sS + bb * RS + t);
        float o0 = acc[p][th][0] * inv + __uint_as_float(sv.x << 16) * skip;
        float o1 = acc[p][th][1] * inv + __uint_as_float(sv.x & 0xffff0000u) * skip;
        float o2 = acc[p][th][2] * inv + __uint_as_float(sv.y << 16) * skip;
        float o3 = acc[p][th][3] * inv + __uint_as_float(sv.y & 0xffff0000u) * skip;
        *(uint2*)(CT + (size_t)bb * L + t) = make_uint2(pack2(o0, o1), pack2(o2, o3));
      }
    }
  }
}

__device__ __forceinline__ void hyfinal_item(unsigned char* smem, CP P, int item) {
  const int tid = threadIdx.x;
  const int rt = item >> 3, ct = item & 7;
  const int row0 = rt * 64, c0 = ct * 64;
  const u16* CT = (const u16*)(P->ws + L0_HY);
  u16* X0 = (u16*)(P->ws + L0_X0C);
  u16* tile = (u16*)smem;
  __syncthreads();
  {
    const int i = tid >> 2, part = tid & 3;
    const u16* src = CT + (size_t)(c0 + i) * MTOT + row0 + part * 16;
    *(uint4*)(tile + i * 72 + part * 16) = *(const uint4*)src;
    *(uint4*)(tile + i * 72 + part * 16 + 8) = *(const uint4*)(src + 8);
  }
  __syncthreads();
  {
    const int r = tid >> 2, cp = tid & 3;
    u16* xp = X0 + (size_t)(row0 + r) * 512 + c0 + cp * 16;
    uint4 x0 = *(const uint4*)xp, x1 = *(const uint4*)(xp + 8);
    unsigned xin[8] = {x0.x, x0.y, x0.z, x0.w, x1.x, x1.y, x1.z, x1.w}, xo[8];
#pragma unroll
    for (int e = 0; e < 8; ++e) {
      float ya = bf2f(tile[(cp * 16 + 2 * e) * 72 + r]), yb = bf2f(tile[(cp * 16 + 2 * e + 1) * 72 + r]);
      xo[e] = pack2(__uint_as_float(xin[e] << 16) * ya, __uint_as_float(xin[e] & 0xffff0000u) * yb);
    }
    *(uint4*)xp = make_uint4(xo[0], xo[1], xo[2], xo[3]);
    *(uint4*)(xp + 8) = make_uint4(xo[4], xo[5], xo[6], xo[7]);
  }
}

__device__ __forceinline__ void rwout_phase(CP P) {
  const int lane = threadIdx.x & 63, wid = threadIdx.x >> 6;
  unsigned char* ws = P->ws;
  const u16* prw = (const u16*)(ws + L0_PRW);
  u16* Y0 = (u16*)(ws + L0_Y0); const u16* Y1 = (const u16*)(ws + L0_Y1); const u16* G = (const u16*)(ws + L0_G);
  const u16* A0 = (const u16*)((unsigned char*)P->out + DO_A0); const u16* A1 = (const u16*)((unsigned char*)P->out + DO_A1);
  const float* mu = P->in[I_MU]; const float* lnw = P->in[I_LNW]; const float* lnb = P->in[I_LNB];
  const float* rkp = P->in[I_RK]; const float* kap = P->in[I_KA];
  for (int row2 = blockIdx.x * 2; row2 < MTOT; row2 += gridDim.x * 2) {
    u16 ry0[4], ry1[4], rg[4], ra0[4], ra1[4], rv[4][3], rr[4][3], rk[4][3];
#pragma unroll
    for (int u = 0; u < 4; ++u) {
      const int row = row2 + (u >> 1), h = wid + 4 * (u & 1), col = h * 64 + lane;
      int sstart, slen; seq_of_row(row, sstart, slen);
      const int rp = (row > sstart) ? row - 1 : row, rn = (row + 1 < sstart + slen) ? row + 1 : row;
      ry0[u] = Y0[(size_t)row * 512 + col]; ry1[u] = Y1[(size_t)row * 512 + col]; rg[u] = G[(size_t)row * 512 + col];
      ra0[u] = A0[(size_t)row * 512 + col]; ra1[u] = A1[(size_t)row * 512 + col];
      const u16* p0 = prw + (size_t)rp * 1792 + col; const u16* p1 = prw + (size_t)row * 1792 + col; const u16* p2 = prw + (size_t)rn * 1792 + col;
      rr[u][0] = p0[0]; rr[u][1] = p1[0]; rr[u][2] = p2[0];
      rk[u][0] = p0[512]; rk[u][1] = p1[512]; rk[u][2] = p2[512];
      rv[u][0] = p0[1024]; rv[u][1] = p1[1024]; rv[u][2] = p2[1024];
    }
#pragma unroll
    for (int u = 0; u < 4; ++u) {
      const int row = row2 + (u >> 1), h = wid + 4 * (u & 1), col = h * 64 + lane;
      int sstart, slen; seq_of_row(row, sstart, slen);
      const bool hp = row > sstart, hn = row + 1 < sstart + slen;
      float y = bf2f(ry0[u]) + bf2f(ry1[u]);
      float mean = wave_sum(y) * (1.f / 64.f);
      float dv = y - mean;
      float var = wave_sum(dv * dv) * (1.f / 64.f);
      float yn = dv * rsqrtf(var + 64e-5f);
      float vc = bf2f(rv[u][1]), rc = bf2f(rr[u][1]), kc = bf2f(rk[u][1]);
      float vs = vc + mu[1024 + col] * (0.5f * ((hp ? bf2f(rv[u][0]) : 0.f) + (hn ? bf2f(rv[u][2]) : 0.f)) - vc);
      float rs = rc + mu[col] * (0.5f * ((hp ? bf2f(rr[u][0]) : 0.f) + (hn ? bf2f(rr[u][2]) : 0.f)) - rc);
      float ks = kc + mu[512 + col] * (0.5f * ((hp ? bf2f(rk[u][0]) : 0.f) + (hn ? bf2f(rk[u][2]) : 0.f)) - kc);
      float bq = rs * ks * rkp[col] * (2.f + (bf2f(ra0[u]) + bf2f(ra1[u]) - 2.f) * kap[col]);
      float bonus = wave_sum(bq);
      float o = (yn * lnw[col] + lnb[col] + bonus * vs) * bf2f(rg[u]);
      Y0[(size_t)row * 512 + col] = f2bf(o);
    }
  }
}

__device__ __forceinline__ void gdnprep_phase(unsigned char* smem, CP P) {
  const int tid = threadIdx.x;
  unsigned char* ws = P->ws;
  u16* pq = (u16*)(ws + L1_PQKV);
  const u16* halo = (const u16*)(ws + OFF_XCTX);
  const float* cw = P->in[I_DNCW];
  u16* raw = (u16*)smem;
  float* wl = (float*)(smem + 130 * 272);
  const int r = tid >> 1, hf = tid & 1;
  for (int it = blockIdx.x; it < 144 * 24; it += gridDim.x) {
    const int tile = it / 24, cb = it % 24, which = cb >> 3;
    const int row0 = tile * 128;
    int sstart, slen; seq_of_row(row0, sstart, slen);
    const bool hp = row0 > sstart, hn = row0 + 128 < sstart + slen;
    __syncthreads();
#pragma unroll
    for (int i = 0; i < 8; ++i) {
      int c = tid + i * 256, rr = c >> 4, kc = c & 15;
      *(uint4*)(raw + (rr + 1) * 136 + kc * 8) = *(const uint4*)(pq + (size_t)(row0 + rr) * 3072 + cb * 128 + kc * 8);
    }
    if (tid < 16) {
      uint4 v = make_uint4(0, 0, 0, 0);
      if (hp) v = *(const uint4*)(halo + (size_t)((tile - 1) * 2 + 1) * 3072 + cb * 128 + tid * 8);
      *(uint4*)(raw + tid * 8) = v;
    } else if (tid < 32) {
      uint4 v = make_uint4(0, 0, 0, 0);
      if (hn) v = *(const uint4*)(halo + (size_t)((tile + 1) * 2) * 3072 + cb * 128 + (tid - 16) * 8);
      *(uint4*)(raw + 129 * 136 + (tid - 16) * 8) = v;
    }
    for (int e = tid; e < 384; e += NTHR) wl[e] = cw[(e >> 7) * 3072 + cb * 128 + (e & 127)];
    __syncthreads();
    float o[64]; float ss = 0.f;
#pragma unroll
    for (int j = 0; j < 8; ++j) {
      const uint4 a4 = *(const uint4*)(raw + r * 136 + hf * 64 + j * 8);
      const uint4 c4 = *(const uint4*)(raw + (r + 1) * 136 + hf * 64 + j * 8);
      const uint4 n4 = *(const uint4*)(raw + (r + 2) * 136 + hf * 64 + j * 8);
      const unsigned a[4] = {a4.x, a4.y, a4.z, a4.w}, c[4] = {c4.x, c4.y, c4.z, c4.w}, n[4] = {n4.x, n4.y, n4.z, n4.w};
#pragma unroll
      for (int e = 0; e < 8; ++e) {
        const int q = e >> 1, sh = (e & 1) ? 0 : 16;
        auto ex = [&](unsigned u) { return __uint_as_float((u << sh) & 0xffff0000u); };
        const int col = hf * 64 + j * 8 + e;
        float v = siluf_(wl[col] * ex(a[q]) + wl[128 + col] * ex(c[q]) + wl[256 + col] * ex(n[q]));
        o[j * 8 + e] = v; ss += v * v;
      }
    }
    ss += __int_as_float(__builtin_amdgcn_mov_dpp(__float_as_int(ss), 0xB1, 0xF, 0xF, true));
    const float sc = (which == 0) ? rsqrtf(ss + 1e-6f) * 0.08838834764831845f : ((which == 1) ? rsqrtf(ss + 1e-6f) : 1.f);
    u16* dst = pq + (size_t)(row0 + r) * 3072 + cb * 128 + hf * 64;
#pragma unroll
    for (int j = 0; j < 8; ++j)
      *(uint4*)(dst + j * 8) = make_uint4(pack2(o[j * 8] * sc, o[j * 8 + 1] * sc), pack2(o[j * 8 + 2] * sc, o[j * 8 + 3] * sc),
                                          pack2(o[j * 8 + 4] * sc, o[j * 8 + 5] * sc), pack2(o[j * 8 + 6] * sc, o[j * 8 + 7] * sc));
  }
  __syncthreads();
  {
    const float* pab = (const float*)(ws + OFF_SMALL + S_PAB);
    float* EG = (float*)(ws + OFF_SMALL + S_EG); float* BE = (float*)(ws + OFF_SMALL + S_BETA);
    const float* alog = P->in[I_DNALOG]; const float* dtb = P->in[I_DNDT];
    for (int e = blockIdx.x * NTHR + tid; e < MTOT * 16; e += gridDim.x * NTHR) {
      const int row = e >> 4, j = e & 15;
      float av = pab[(size_t)row * 32 + j], bv = pab[(size_t)row * 32 + 16 + j];
      float g = -__expf(alog[j]) * softplusf_(av + dtb[j]);
      EG[e] = g;
      BE[e] = sigmoidf_(bv);
    }
  }
}

__device__ __forceinline__ void gdnscan_item(float* lds, CP P, int item) {
  const int tid = threadIdx.x;
  const int cgq = item & 3, dir = (item >> 2) & 1, h = (item >> 3) & 7, b = item >> 6;
  const int kq = tid & 15, cl = tid >> 4;
  unsigned char* ws = P->ws;
  const u16* pq = (const u16*)(ws + L1_PQKV);
  const float* EG = (const float*)(ws + OFF_SMALL + S_EG); const float* BE = (const float*)(ws + OFF_SMALL + S_BETA);
  u16* O = (u16*)(ws + (dir ? L1_O1 : L1_O0));
  const int SSTR = 292, BUFSZ = 16 * 292;
  __syncthreads();
  v2f s[8];
#pragma unroll
  for (int j = 0; j < 8; ++j) s[j] = (v2f){0.f, 0.f};
  const int qst = tid >> 4, qc8 = tid & 15;
  const int vst = (tid & 63) >> 2, vc8 = tid & 3;
  const int wv = tid >> 6;
  for (int seq = 0; seq < 2; ++seq) {
    const int Ls = seq ? 2048 : 256;
    const int rowbase = seq ? b * 2048 : MLAT + b * 256;
    const int nchunk = Ls / 16;
    uint4 Q1, K1, V1; float sc0 = 0.f, sc1 = 0.f;
    auto gl = [&](int c) {
      {
        int i = c * 16 + qst; int t = dir ? (Ls - 1 - i) : i; size_t row = rowbase + t;
        const u16* p = pq + row * 3072 + h * 128 + qc8 * 8;
        Q1 = *(const uint4*)p; K1 = *(const uint4*)(p + 1024);
      }
      if (wv == 0) {
        int i = c * 16 + vst; int t = dir ? (Ls - 1 - i) : i; size_t row = rowbase + t;
        V1 = *(const uint4*)(pq + row * 3072 + 2048 + h * 128 + cgq * 32 + vc8 * 8);
      } else if (wv == 1 && (tid & 63) < 16) {
        int i = c * 16 + (tid & 63); int t = dir ? (Ls - 1 - i) : i; size_t row = rowbase + t;
        sc0 = EG[row * 16 + dir * 8 + h]; sc1 = BE[row * 16 + dir * 8 + h];
      }
    };
    auto sw = [&](int buf) {
      float* bp = lds + buf * BUFSZ;
      {
        float* sp = bp + qst * SSTR + qc8 * 4;
        *(float4*)(sp) = make_float4(__uint_as_float(Q1.x << 16), __uint_as_float(Q1.x & 0xffff0000u), __uint_as_float(Q1.y << 16), __uint_as_float(Q1.y & 0xffff0000u));
        *(float4*)(sp + 64) = make_float4(__uint_as_float(Q1.z << 16), __uint_as_float(Q1.z & 0xffff0000u), __uint_as_float(Q1.w << 16), __uint_as_float(Q1.w & 0xffff0000u));
        *(float4*)(sp + 128) = make_float4(__uint_as_float(K1.x << 16), __uint_as_float(K1.x & 0xffff0000u), __uint_as_float(K1.y << 16), __uint_as_float(K1.y & 0xffff0000u));
        *(float4*)(sp + 192) = make_float4(__uint_as_float(K1.z << 16), __uint_as_float(K1.z & 0xffff0000u), __uint_as_float(K1.w << 16), __uint_as_float(K1.w & 0xffff0000u));
      }
      if (wv == 0) {
        float* sp = bp + vst * SSTR + 256 + vc8 * 8;
        *(float4*)(sp) = make_float4(__uint_as_float(V1.x << 16), __uint_as_float(V1.x & 0xffff0000u), __uint_as_float(V1.y << 16), __uint_as_float(V1.y & 0xffff0000u));
        *(float4*)(sp + 4) = make_float4(__uint_as_float(V1.z << 16), __uint_as_float(V1.z & 0xffff0000u), __uint_as_float(V1.w << 16), __uint_as_float(V1.w & 0xffff0000u));
      } else if (wv == 1 && (tid & 63) < 16) {
        bp[(tid & 63) * SSTR + 288] = sc0; bp[(tid & 63) * SSTR + 289] = sc1;
      }
    };
    gl(0);
    __syncthreads();
    sw(0);
    __syncthreads();
    for (int c = 0; c < nchunk; ++c) {
      const int buf = c & 1;
      if (c + 1 < nchunk) gl(c + 1);
      v2f okeep = (v2f){0.f, 0.f};
      float4 qpa = make_float4(0.f, 0.f, 0.f, 0.f), qpb = make_float4(0.f, 0.f, 0.f, 0.f);
      float4 qan, qbn, kan, kbn; v2f vvn; float egn, betan;
      {
        const float* sp = lds + buf * BUFSZ;
        qan = *(const float4*)(sp + kq * 4); qbn = *(const float4*)(sp + 64 + kq * 4);
        kan = *(const float4*)(sp + 128 + kq * 4); kbn = *(const float4*)(sp + 192 + kq * 4);
        vvn = *(const v2f*)(sp + 256 + cl * 2); egn = sp[288]; betan = sp[289];
      }
#pragma unroll
      for (int st = 0; st < 16; ++st) {
        const float4 qa = qan, qb = qbn, ka = kan, kb = kbn; const v2f vv = vvn; const float eg = egn, beta = betan;
        if (st < 15) {
          const float* sp = lds + buf * BUFSZ + (st + 1) * SSTR;
          qan = *(const float4*)(sp + kq * 4); qbn = *(const float4*)(sp + 64 + kq * 4);
          kan = *(const float4*)(sp + 128 + kq * 4); kbn = *(const float4*)(sp + 192 + kq * 4);
          vvn = *(const v2f*)(sp + 256 + cl * 2); egn = sp[288]; betan = sp[289];
        }
        __builtin_amdgcn_sched_barrier(0);
        v2f pk = (s[0] * ka.x + s[1] * ka.y + s[2] * ka.z + s[3] * ka.w) + (s[4] * kb.x + s[5] * kb.y + s[6] * kb.z + s[7] * kb.w);
        v2f po = (s[0] * qpa.x + s[1] * qpa.y + s[2] * qpa.z + s[3] * qpa.w) + (s[4] * qpb.x + s[5] * qpb.y + s[6] * qpb.z + s[7] * qpb.w);
        red16x2(pk, po);
        if (st > 0) { okeep.x = (kq == st - 1) ? po.x : okeep.x; okeep.y = (kq == st - 1) ? po.y : okeep.y; }
        const v2f cc = (vv - pk * eg) * beta;
        s[0] = s[0] * eg + cc * ka.x; s[1] = s[1] * eg + cc * ka.y; s[2] = s[2] * eg + cc * ka.z; s[3] = s[3] * eg + cc * ka.w;
        s[4] = s[4] * eg + cc * kb.x; s[5] = s[5] * eg + cc * kb.y; s[6] = s[6] * eg + cc * kb.z; s[7] = s[7] * eg + cc * kb.w;
        qpa = qa; qpb = qb;
        __builtin_amdgcn_sched_barrier(0);
      }
      {
        v2f po = (s[0] * qpa.x + s[1] * qpa.y + s[2] * qpa.z + s[3] * qpa.w) + (s[4] * qpb.x + s[5] * qpb.y + s[6] * qpb.z + s[7] * qpb.w);
        v2f dummy = po;
        red16x2(po, dummy);
        okeep.x = (kq == 15) ? po.x : okeep.x; okeep.y = (kq == 15) ? po.y : okeep.y;
      }
      if (seq) {
        int i = c * 16 + kq; int t = dir ? (Ls - 1 - i) : i;
        *(unsigned*)(O + (size_t)(rowbase + t) * 1024 + h * 128 + cgq * 32 + cl * 2) = pack2(okeep.x, okeep.y);
      }
      if (c + 1 < nchunk) sw(buf ^ 1);
      __syncthreads();
    }
  }
}

#define A_RL(i_, j_) __int_as_float(__builtin_amdgcn_readlane(__float_as_int(areg[((i_) * 16 + (j_)) >> 6]), ((i_) * 16 + (j_)) & 63))
__device__ __forceinline__ void gdnchunk_item(unsigned char* smem, CP P, int item) {
  const int tid = threadIdx.x, lane = tid & 63, w = tid >> 6, fr = lane & 15, fq = lane >> 4;
  const int cgq = item & 1, dir = (item >> 1) & 1, h = (item >> 2) & 7, b = item >> 5;
  unsigned char* ws = P->ws;
  const u16* pq = (const u16*)(ws + L1_PQKV);
  const float* GG = (const float*)(ws + OFF_SMALL + S_EG); const float* BE = (const float*)(ws + OFF_SMALL + S_BETA);
  u16* O = (u16*)(ws + (dir ? L1_O1 : L1_O0));
  u16* Kb = (u16*)(smem + 0);
  u16* Qb = (u16*)(smem + 4352);
  u16* Wb = (u16*)(smem + 8704);
  u16* SbT = (u16*)(smem + 13056);
  u16* KgT = (u16*)(smem + 30464);
  u16* VNT = (u16*)(smem + 40704);
  u16* RT = (u16*)(smem + 45824);
  u16* Pb = (u16*)(smem + 50944);
  u16* Tb = (u16*)(smem + 52224);
  float* Am = (float*)(smem + 53504);
  float* gsc = (float*)(smem + 54528);
  float* Vf = (float*)(smem + 54848);
  __syncthreads();
  for (int e = tid; e < 58944 / 4; e += NTHR) ((unsigned*)smem)[e] = 0u;
  f32x4 accS[4][2];
#pragma unroll
  for (int a = 0; a < 4; ++a)
#pragma unroll
    for (int c = 0; c < 2; ++c) accS[a][c] = (f32x4){0.f, 0.f, 0.f, 0.f};
  const int si = tid >> 4, sc8 = tid & 15;
  const int vi = (tid & 127) >> 3, vc8 = tid & 7;
  __syncthreads();
  for (int seq = 0; seq < 2; ++seq) {
    const int Ls = seq ? 2048 : 256;
    const int rowbase = seq ? b * 2048 : MLAT + b * 256;
    const int nchunk = Ls / 16;
    uint4 Q1, K1, V1 = make_uint4(0, 0, 0, 0); float sg = 0.f, sb = 0.f;
    auto gl = [&](int c) {
      {
        int i = c * 16 + si; int t = dir ? (Ls - 1 - i) : i; size_t row = rowbase + t;
        const u16* p = pq + row * 3072 + h * 128 + sc8 * 8;
        Q1 = *(const uint4*)p; K1 = *(const uint4*)(p + 1024);
      }
      if (w < 2) {
        int i = c * 16 + vi; int t = dir ? (Ls - 1 - i) : i; size_t row = rowbase + t;
        V1 = *(const uint4*)(pq + row * 3072 + 2048 + h * 128 + cgq * 64 + vc8 * 8);
      }
      {
        int i = c * 16 + (lane & 15); int t = dir ? (Ls - 1 - i) : i; size_t row = rowbase + t;
        sg = GG[row * 16 + dir * 8 + h]; sb = BE[row * 16 + dir * 8 + h];
      }
    };
    gl(0);
    for (int c = 0; c < nchunk; ++c) {
      *(uint4*)(Qb + si * 136 + sc8 * 8) = Q1;
      *(uint4*)(Kb + si * 136 + sc8 * 8) = K1;
      {
        float v = sg;
        v += __int_as_float(__builtin_amdgcn_update_dpp(0, __float_as_int(v), 0x111, 0xf, 0xf, false));
        v += __int_as_float(__builtin_amdgcn_update_dpp(0, __float_as_int(v), 0x112, 0xf, 0xf, false));
        v += __int_as_float(__builtin_amdgcn_update_dpp(0, __float_as_int(v), 0x114, 0xf, 0xf, false));
        v += __int_as_float(__builtin_amdgcn_update_dpp(0, __float_as_int(v), 0x118, 0xf, 0xf, false));
        const float tot = __int_as_float(__builtin_amdgcn_readlane(__float_as_int(v), 15));
        if (w == 1 && lane < 16) { gsc[lane] = sg; gsc[16 + lane] = sb; gsc[32 + lane] = v; gsc[48 + lane] = __expf(v); gsc[64 + lane] = __expf(tot - v); }
        const float gcs = __shfl(v, (lane & 48) | (si & 15)), bts = __shfl(sb, (lane & 48) | (si & 15));
        const float el = __expf(tot - gcs), bw = bts * __expf(gcs);
        const unsigned kk4[4] = {K1.x, K1.y, K1.z, K1.w};
        unsigned kw[4];
#pragma unroll
        for (int e = 0; e < 8; e += 2) {
          const float k0 = __uint_as_float(kk4[e >> 1] << 16), k1 = __uint_as_float(kk4[e >> 1] & 0xffff0000u);
          KgT[(sc8 * 8 + e) * 40 + si] = f2bf(k0 * el);
          KgT[(sc8 * 8 + e + 1) * 40 + si] = f2bf(k1 * el);
          kw[e >> 1] = pack2(k0 * bw, k1 * bw);
        }
        *(uint4*)(Wb + si * 136 + sc8 * 8) = make_uint4(kw[0], kw[1], kw[2], kw[3]);
        const float bt = __shfl(sb, (lane & 48) | vi);
        if (w < 2) {
          float* vp = Vf + vi * 64 + vc8 * 8;
          *(float4*)vp = make_float4(bt * __uint_as_float(V1.x << 16), bt * __uint_as_float(V1.x & 0xffff0000u), bt * __uint_as_float(V1.y << 16), bt * __uint_as_float(V1.y & 0xffff0000u));
          *(float4*)(vp + 4) = make_float4(bt * __uint_as_float(V1.z << 16), bt * __uint_as_float(V1.z & 0xffff0000u), bt * __uint_as_float(V1.w << 16), bt * __uint_as_float(V1.w & 0xffff0000u));
        }
      }
      __syncthreads();
      if (c + 1 < nchunk) gl(c + 1);
      f32x4 acco[2];
      acco[0] = (f32x4){0.f, 0.f, 0.f, 0.f}; acco[1] = (f32x4){0.f, 0.f, 0.f, 0.f};
      if (w < 2) {
        f32x4 a4 = (f32x4){0.f, 0.f, 0.f, 0.f};
        const u16* ab = (w == 0) ? Kb : Qb;
#pragma unroll
        for (int ks = 0; ks < 4; ++ks) {
          const bf16x8 fa = *(const bf16x8*)(ab + fr * 136 + ks * 32 + fq * 8);
          const bf16x8 fb = *(const bf16x8*)(Kb + fr * 136 + ks * 32 + fq * 8);
          a4 = __builtin_amdgcn_mfma_f32_16x16x32_bf16(fa, fb, a4, 0, 0, 0);
        }
        const float gj = gsc[32 + fr];
#pragma unroll
        for (int jj = 0; jj < 4; ++jj) {
          const int i = fq * 4 + jj;
          const float dec = __expf(fminf(gsc[32 + i] - gj, 0.f));
          if (w == 0) Am[i * 16 + fr] = (fr < i) ? gsc[16 + i] * a4[jj] * dec : 0.f;
          else Pb[i * 40 + fr] = f2bf((fr <= i) ? a4[jj] * dec : 0.f);
        }
      } else {
#pragma unroll
        for (int q = 0; q < 2; ++q) {
          const int nt = (w - 2) + 2 * q;
          f32x4 ks4 = (f32x4){0.f, 0.f, 0.f, 0.f};
#pragma unroll
          for (int ks = 0; ks < 4; ++ks) {
            const bf16x8 fb = *(const bf16x8*)(SbT + (nt * 16 + fr) * 136 + ks * 32 + fq * 8);
            const bf16x8 fa = *(const bf16x8*)(Qb + fr * 136 + ks * 32 + fq * 8);
            const bf16x8 fw = *(const bf16x8*)(Wb + fr * 136 + ks * 32 + fq * 8);
            acco[q] = __builtin_amdgcn_mfma_f32_16x16x32_bf16(fa, fb, acco[q], 0, 0, 0);
            ks4 = __builtin_amdgcn_mfma_f32_16x16x32_bf16(fw, fb, ks4, 0, 0, 0);
          }
          float rr[4];
#pragma unroll
          for (int jj = 0; jj < 4; ++jj) rr[jj] = Vf[(fq * 4 + jj) * 64 + nt * 16 + fr] - ks4[jj];
          *(uint2*)(RT + (nt * 16 + fr) * 40 + fq * 4) = make_uint2(pack2(rr[0], rr[1]), pack2(rr[2], rr[3]));
        }
      }
      __syncthreads();
      if (w == 0) {
        float areg[4];
#pragma unroll
        for (int q = 0; q < 4; ++q) areg[q] = Am[q * 64 + lane];
        float x[16];
#pragma unroll
        for (int i = 0; i < 16; ++i) x[i] = (i == fr) ? 1.f : 0.f;
#pragma unroll
        for (int j2 = 0; j2 < 15; ++j2)
#pragma unroll
          for (int i = j2 + 1; i < 16; ++i) x[i] -= A_RL(i, j2) * x[j2];
        if (lane < 16) {
#pragma unroll
          for (int i = 0; i < 16; ++i) Tb[i * 40 + lane] = f2bf(x[i]);
        }
      }
      __syncthreads();
      if (w >= 2) {
        const bf16x8 ft = *(const bf16x8*)(Tb + fr * 40 + fq * 8);
#pragma unroll
        for (int q = 0; q < 2; ++q) {
          const int nt = (w - 2) + 2 * q;
          const bf16x8 fb = *(const bf16x8*)(RT + (nt * 16 + fr) * 40 + fq * 8);
          const f32x4 vn = __builtin_amdgcn_mfma_f32_16x16x32_bf16(ft, fb, (f32x4){0.f, 0.f, 0.f, 0.f}, 0, 0, 0);
          *(uint2*)(VNT + (nt * 16 + fr) * 40 + fq * 4) = make_uint2(pack2(vn[0], vn[1]), pack2(vn[2], vn[3]));
        }
      }
      __syncthreads();
      if (w >= 2) {
        const bf16x8 fa = *(const bf16x8*)(Pb + fr * 40 + fq * 8);
#pragma unroll
        for (int q = 0; q < 2; ++q) {
          const int nt = (w - 2) + 2 * q;
          f32x4 ao = acco[q];
#pragma unroll
          for (int jj = 0; jj < 4; ++jj) ao[jj] *= gsc[48 + fq * 4 + jj];
          const bf16x8 fb = *(const bf16x8*)(VNT + (nt * 16 + fr) * 40 + fq * 8);
          ao = __builtin_amdgcn_mfma_f32_16x16x32_bf16(fa, fb, ao, 0, 0, 0);
          if (seq) {
#pragma unroll
            for (int jj = 0; jj < 4; ++jj) {
              const int i = c * 16 + fq * 4 + jj; const int t = dir ? (Ls - 1 - i) : i;
              O[(size_t)(rowbase + t) * 1024 + h * 128 + cgq * 64 + nt * 16 + fr] = f2bf(ao[jj]);
            }
          }
        }
      }
      {
        const float egl = gsc[48 + 15];
        const bf16x8 fb0 = *(const bf16x8*)(KgT + ((2 * w) * 16 + fr) * 40 + fq * 8);
        const bf16x8 fb1 = *(const bf16x8*)(KgT + ((2 * w + 1) * 16 + fr) * 40 + fq * 8);
#pragma unroll
        for (int vt = 0; vt < 4; ++vt) {
          const bf16x8 fa = *(const bf16x8*)(VNT + (vt * 16 + fr) * 40 + fq * 8);
          f32x4 a0 = accS[vt][0], a1 = accS[vt][1];
#pragma unroll
          for (int jj = 0; jj < 4; ++jj) { a0[jj] *= egl; a1[jj] *= egl; }
          a0 = __builtin_amdgcn_mfma_f32_16x16x32_bf16(fa, fb0, a0, 0, 0, 0);
          a1 = __builtin_amdgcn_mfma_f32_16x16x32_bf16(fa, fb1, a1, 0, 0, 0);
          accS[vt][0] = a0; accS[vt][1] = a1;
#pragma unroll
          for (int jj = 0; jj < 4; ++jj) {
            SbT[(vt * 16 + fq * 4 + jj) * 136 + (2 * w) * 16 + fr] = f2bf(a0[jj]);
            SbT[(vt * 16 + fq * 4 + jj) * 136 + (2 * w + 1) * 16 + fr] = f2bf(a1[jj]);
          }
        }
      }
      __syncthreads();
    }
  }
}

__device__ __forceinline__ void gdngate_phase(CP P) {
  const int lane = threadIdx.x & 63, wid = threadIdx.x >> 6;
  unsigned char* ws = P->ws;
  u16* O0 = (u16*)(ws + L1_O0); const u16* O1 = (const u16*)(ws + L1_O1); const u16* PZ = (const u16*)(ws + L1_PZ);
  const float nw0 = P->in[I_DNNORM][lane * 2], nw1 = P->in[I_DNNORM][lane * 2 + 1];
  for (int row2 = blockIdx.x * 2; row2 < MLAT; row2 += gridDim.x * 2) {
    unsigned ra[4], rb[4], rz[4];
#pragma unroll
    for (int u = 0; u < 4; ++u) {
      const size_t idx = (size_t)(row2 + (u >> 1)) * 1024 + (wid + 4 * (u & 1)) * 128 + lane * 2;
      ra[u] = *(const unsigned*)(O0 + idx); rb[u] = *(const unsigned*)(O1 + idx); rz[u] = *(const unsigned*)(PZ + idx);
    }
#pragma unroll
    for (int u = 0; u < 4; ++u) {
      const size_t idx = (size_t)(row2 + (u >> 1)) * 1024 + (wid + 4 * (u & 1)) * 128 + lane * 2;
      float o1 = __uint_as_float(ra[u] << 16) + __uint_as_float(rb[u] << 16);
      float o2 = __uint_as_float(ra[u] & 0xffff0000u) + __uint_as_float(rb[u] & 0xffff0000u);
      float ss = wave_sum(o1 * o1 + o2 * o2);
      float rs = rsqrtf(ss * (1.f / 128.f) + 1e-6f);
      float z1 = __uint_as_float(rz[u] << 16), z2 = __uint_as_float(rz[u] & 0xffff0000u);
      *(unsigned*)(O0 + idx) = pack2(o1 * rs * nw0 * siluf_(z1), o2 * rs * nw1 * siluf_(z2));
    }
  }
}

__device__ __forceinline__ void final_norm_phase(CP P) {
  const int lane = threadIdx.x & 63, wid = threadIdx.x >> 6;
  const float* nw = P->in[I_FNORM];
  for (int row = blockIdx.x * 4 + wid; row < MLAT; row += gridDim.x * 4) {
    float* src = P->out + (size_t)row * 1024;
    float4 v[4]; float ss = 0.f;
#pragma unroll
    for (int i = 0; i < 4; ++i) { v[i] = *(const float4*)(src + (i * 64 + lane) * 4); ss += v[i].x * v[i].x + v[i].y * v[i].y + v[i].z * v[i].z + v[i].w * v[i].w; }
    ss = wave_sum(ss);
    const float rs = rsqrtf(ss * (1.f / 1024.f) + 1e-6f);
#pragma unroll
    for (int i = 0; i < 4; ++i) {
      int c = (i * 64 + lane) * 4;
      float4 w = *(const float4*)(nw + c);
      *(float4*)(src + c) = make_float4(v[i].x * rs * w.x, v[i].y * rs * w.y, v[i].z * rs * w.z, v[i].w * rs * w.w);
    }
  }
}

#ifndef PMASK
#define PMASK 0xFFFFFFFFu
#endif
#define PM(k) if (PMASK & (1u << (k))) if (CP P = launder(P0))
__global__ void __launch_bounds__(NTHR, 2) fwd_megakernel(Params Parg) {
  extern __shared__ __attribute__((aligned(16))) unsigned char smem[];
  cg::grid_group grid = cg::this_grid();
  float* ldsf = (float*)smem;
  CP P0 = (CP)__builtin_amdgcn_kernarg_segment_ptr();
  unsigned char* ws = P0->ws;
  const int G = gridDim.x, bx = blockIdx.x;
  float* modv = (float*)(ws + OFF_SMALL + S_MODV);
  float* xctx = (float*)(ws + OFF_XCTX);
  volatile LAS unsigned* xst = (volatile LAS unsigned*)((LAS unsigned char*)smem + (LDS_BYTES - 32));
  if (threadIdx.x < 2) xst[threadIdx.x] = 0u;
  __syncthreads();
  XcdBarrier xbar = xcd_barrier_post((unsigned*)(ws + OFF_SMALL + S_BAR), xst);

  PM(0) {
    if (bx == 0) { float* hn = (float*)(ws + OFF_SMALL + S_HNORM); for (int e = threadIdx.x; e < 1024; e += NTHR) hn[e] = 0.f;
      if (threadIdx.x == 0) *(int*)(ws + OFF_SMALL + S_PAB) = 0; }
    for (int it = bx; it < 384; it += G) modv_item(ldsf, P, it);
    for (int it = bx; it < 576; it += G) h3_item(ldsf, P, it);
    wconv_layer(ldsf, P, 0, G - 1 - bx, G);
  }
  if (gridDim.x == 0x7fffffffu) grid.sync();
  xcd_barrier(xbar);
  PM(1) {
    for (int it = bx; it < 288; it += G) kun_item(ldsf, P, it);
    norm_phase(P->in[I_X], P->in[I_CTX], MTOT, P->in[I_NMIX], modv, 0, 1, (u16*)(ws + L0_H));
  }
  xcd_barrier(xbar);
  PM(2) {
    ASrc a{(const u16*)(ws + L0_H), 1024, (const u16*)(ws + L0_H), 1024, 1 << 30};
    gemm_phase(smem, a, (const u16*)(ws + W_IN), MTOT, 3328, 1024, EpiInProj0{(u16*)(ws + L0_PRW), (u16*)(ws + L0_PHY)});
  }
  xcd_barrier(xbar);
  PM(3) {
    for (int it = bx; it < 1152 * 2; it += G) { if (it < 1152) hyprep_item(P, it); else lrprep_item(P, it - 1152); }
  }
  xcd_barrier(xbar);
  PM(3) {
    u16* A0p = (u16*)((unsigned char*)P->out + DO_A0); u16* A1p = (u16*)((unsigned char*)P->out + DO_A1);
    u16* OM0p = (u16*)((unsigned char*)P->out + DO_OM0); u16* OM1p = (u16*)(ws + L0_OM1);
    const u16* LRp = (const u16*)(ws + L0_LR);
    { ASrc a{LRp, 256, LRp, 256, 1 << 30};
      gemm_phase(smem, a, (const u16*)(ws + W_LRW), MTOT, 1024, 64, EpiLrW{OM0p, OM1p, P->in[I_RW0]}); }
    { ASrc a{LRp + 64, 256, LRp + 64, 256, 1 << 30};
      gemm_phase(smem, a, (const u16*)(ws + W_LRA), MTOT, 1024, 64, EpiLrA{A0p, A1p, P->in[I_A0]}); }
    { ASrc a{LRp + 128, 256, LRp + 128, 256, 1 << 30};
      gemm_phase(smem, a, (const u16*)(ws + W_LRG), MTOT, 512, 128, EpiLrG{(u16*)(ws + L0_G)}); }
  }
  xcd_barrier(xbar);
  PM(4) {
    if (bx < (G >> 1)) for (int it = bx; it < 256; it += (G >> 1)) rwscan_item(ldsf, P, it);
    int* qctr = (int*)(ws + OFF_SMALL + S_PAB);
    int* qsh = (int*)(smem + LDS_BYTES - 16);
    for (;;) {
      __syncthreads();
      if (threadIdx.x == 0) *qsh = atomicAdd(qctr, 1);
      __syncthreads();
      const int it = *qsh;
      if (it >= 1024) break;
      hymfma_item(smem, P, it);
    }
  }
  xcd_barrier(xbar);
  PM(5) { rwout_phase(P); for (int it = bx; it < 288 * 8; it += G) hyfinal_item(smem, P, it); }
  xcd_barrier(xbar);
  PM(6) {
    ASrc a{(const u16*)(ws + L0_Y0), 512, (const u16*)(ws + L0_X0C), 512, 512};
    gemm_phase(smem, a, (const u16*)(ws + W_OUT), MTOT, 1024, 1024, EpiResid{P->in[I_X], P->in[I_CTX], P->out, xctx, modv + 2 * 1024});
  }
  xcd_barrier(xbar);
  PM(7) norm_phase(P->out, xctx, MTOT, P->in[I_NMLP], modv, 3, 4, (u16*)(ws + L0_H));
  xcd_barrier(xbar);
  PM(8) {
    ASrc a{(const u16*)(ws + L0_H), 1024, (const u16*)(ws + L0_H), 1024, 1 << 30};
    gemm_phase(smem, a, (const u16*)(ws + W_1), MTOT, 4096, 1024, EpiRelu2{(u16*)(ws + L0_U)});
  }
  xcd_barrier(xbar);
  PM(9) {
    ASrc a{(const u16*)(ws + L0_U), 4096, (const u16*)(ws + L0_U), 4096, 1 << 30};
    gemm_phase(smem, a, (const u16*)(ws + W_2), MTOT, 1024, 4096, EpiResid{P->out, xctx, P->out, xctx, modv + 5 * 1024});
  }
  xcd_barrier(xbar);
  const float* modv1 = modv + 9 * 6144;
  PM(10) {
    norm_phase(P->out, xctx, MTOT, P->in[I_NMIX] + 1024, modv1, 0, 1, (u16*)(ws + L1_H));
    wconv_layer(ldsf, P, 1, bx, G);
  }
  xcd_barrier(xbar);
  PM(11) {
    ASrc a{(const u16*)(ws + L1_H), 1024, (const u16*)(ws + L1_H), 1024, 1 << 30};
    gemm_phase(smem, a, (const u16*)(ws + W_IN), MTOT, 4224, 1024,
               EpiInProj1{(u16*)(ws + L1_PQKV), (u16*)(ws + L1_PZ), (float*)(ws + OFF_SMALL + S_PAB), (u16*)(ws + OFF_XCTX)});
  }
  xcd_barrier(xbar);
  PM(12) gdnprep_phase(smem, P);
  xcd_barrier(xbar);
  PM(13) { if (bx < (G >> 1)) for (int it = bx; it < 256; it += (G >> 1)) gdnchunk_item(smem, P, it); }
  xcd_barrier(xbar);
  PM(14) gdngate_phase(P);
  xcd_barrier(xbar);
  PM(15) {
    ASrc a{(const u16*)(ws + L1_O0), 1024, (const u16*)(ws + L1_O0), 1024, 1 << 30};
    gemm_phase(smem, a, (const u16*)(ws + W_OUT), MLAT, 1024, 1024, EpiResid{P->out, xctx, P->out, xctx, modv1 + 2 * 1024});
  }
  xcd_barrier(xbar);
  PM(16) norm_phase(P->out, xctx, MLAT, P->in[I_NMLP] + 1024, modv1, 3, 4, (u16*)(ws + L1_H));
  xcd_barrier(xbar);
  PM(17) {
    ASrc a{(const u16*)(ws + L1_H), 1024, (const u16*)(ws + L1_H), 1024, 1 << 30};
    gemm_phase(smem, a, (const u16*)(ws + W_1), MLAT, 4096, 1024, EpiRelu2{(u16*)(ws + L1_U)});
  }
  xcd_barrier(xbar);
  PM(18) {
    ASrc a{(const u16*)(ws + L1_U), 4096, (const u16*)(ws + L1_U), 4096, 1 << 30};
    gemm_phase(smem, a, (const u16*)(ws + W_2), MLAT, 1024, 4096, EpiResid{P->out, xctx, P->out, xctx, modv1 + 5 * 1024});
  }
  xcd_barrier(xbar);
  PM(19) final_norm_phase(P);
}

extern "C" void kernel_launch(void* const* d_in, const int* in_sizes, int n_in, void* d_out, int out_size, void* d_ws, size_t ws_size,
                              hipStream_t stream) {
  static int grid_blocks = 0;
  if (!grid_blocks) {
    int dev = 0, cus = 0, per_cu = 0;
    hipGetDevice(&dev);
    hipDeviceGetAttribute(&cus, hipDeviceAttributeMultiprocessorCount, dev);
    hipFuncSetAttribute((const void*)fwd_megakernel, hipFuncAttributeMaxDynamicSharedMemorySize, LDS_BYTES);
    hipOccupancyMaxActiveBlocksPerMultiprocessor(&per_cu, (const void*)fwd_megakernel, NTHR, LDS_BYTES);
    if (per_cu < 1) per_cu = 1;
    if (per_cu > 2) per_cu = 2;
    grid_blocks = cus * per_cu;
    if (ws_size < WS_NEED) fprintf(stderr, "kernel_launch: workspace too small: %zu < %zu\n", ws_size, (size_t)WS_NEED);
  }
  Params p{};
  for (int i = 0; i < 41; ++i) p.in[i] = (const float*)d_in[i];
  p.out = (float*)d_out;
  p.ws = (unsigned char*)d_ws;
  (void)hipMemsetAsync((unsigned char*)d_ws + OFF_SMALL + S_BAR, 0, XCD_BAR_WORDS * 4, stream);
  void* args[] = {&p};
  hipError_t e = hipLaunchCooperativeKernel((const void*)fwd_megakernel, dim3(grid_blocks), dim3(NTHR), args, LDS_BYTES, stream);
  if (e != hipSuccess) fprintf(stderr, "cooperative launch failed: %s (grid %d)\n", hipGetErrorString(e), grid_blocks);
}
```
